# Optimizing an MI355X kernel written in HIP

```python
import math
import jax, jax.numpy as jnp
from jax import lax
import numpy as np

D_MODEL = 1024
BATCH = 8
SEQ = 4096
DEPTH = 1

RMS_EPS = 1e-6
MIX_WIDTH = D_MODEL
POOL_WIDTH = MIX_WIDTH // 2
SSM_WIDTH = MIX_WIDTH - POOL_WIDTH
POOL_WINDOWS = (2, 4, 8, 16)
POOL_GROUPS = len(POOL_WINDOWS)
POOL_GROUP_DIM = POOL_WIDTH // POOL_GROUPS
SSM_GROUP_DIM = 16
SSM_GROUPS = SSM_WIDTH // SSM_GROUP_DIM
SSM_STATE = 64
DT_MIN, DT_MAX = 1e-3, 1e-1
N_EXPERTS = 32
TOP_K = 4
D_FF = D_MODEL
SWIGLU_ALPHA = 1.702
SWIGLU_LIMIT = 7.0
MOE_BLOCK = 256
IN_PROJ_WIDTH = MIX_WIDTH + 2 * D_MODEL

kernel_name = "hybrid_pool_s5_gated_moe_block"


def _rmsnorm(x, g):
    xf = x.astype(jnp.float32)
    y = xf * lax.rsqrt(jnp.mean(xf * xf, axis=-1, keepdims=True) + RMS_EPS)
    return (y * g.astype(jnp.float32)).astype(x.dtype)


def _pool_mixer(u, pool_w, pool_scale):
    bsz, t_len, _ = u.shape
    uf = u.astype(jnp.float32)
    pos = jnp.arange(1, t_len + 1, dtype=jnp.float32)[None, :, None]
    outs = []
    for g, w in enumerate(POOL_WINDOWS):
        ug = uf[..., g * POOL_GROUP_DIM:(g + 1) * POOL_GROUP_DIM]
        cs = jnp.cumsum(ug, axis=1)
        lag = jnp.pad(cs[:, :t_len - w], ((0, 0), (w, 0), (0, 0)))
        mean = (cs - lag) / jnp.minimum(pos, float(w))
        outs.append(mean - ug)
    d = jnp.stack(outs, axis=2).astype(u.dtype)
    y = jnp.einsum('btgc,gcd->btgd', d, pool_w).reshape(bsz, t_len, POOL_WIDTH)
    return y * pool_scale


def _complex_affine_combine(e1, e2):
    ar1, ai1, br1, bi1 = e1
    ar2, ai2, br2, bi2 = e2
    ar = ar2 * ar1 - ai2 * ai1
    ai = ar2 * ai1 + ai2 * ar1
    br = ar2 * br1 - ai2 * bi1 + br2
    bi = ar2 * bi1 + ai2 * br1 + bi2
    return (ar, ai, br, bi)


def _ssm_mixer(u, lam_re, lam_im, log_dt, b_re, b_im, c_re, c_im, d_skip, glu_w, glu_b):
    f32 = jnp.float32
    bsz, t_len, _ = u.shape
    uf = u.astype(f32).reshape(bsz, t_len, SSM_GROUPS, SSM_GROUP_DIM)
    lr, li = lam_re.astype(f32), lam_im.astype(f32)
    dt = jnp.exp(log_dt.astype(f32))[:, None]
    mag = jnp.exp(lr * dt)
    lb_re, lb_im = mag * jnp.cos(li * dt), mag * jnp.sin(li * dt)
    den = lr * lr + li * li
    xr, xi = lb_re - 1.0, lb_im
    f_re = (xr * lr + xi * li) / den
    f_im = (xi * lr - xr * li) / den
    br, bi = b_re.astype(f32), b_im.astype(f32)
    bb_re = f_re[..., None] * br - f_im[..., None] * bi
    bb_im = f_re[..., None] * bi + f_im[..., None] * br
    bu_re = jnp.einsum('btgp,gnp->btgn', uf, bb_re)
    bu_im = jnp.einsum('btgp,gnp->btgn', uf, bb_im)
    a_re = jnp.broadcast_to(lb_re, bu_re.shape)
    a_im = jnp.broadcast_to(lb_im, bu_im.shape)
    _, _, s_re, s_im = lax.associative_scan(
        _complex_affine_combine, (a_re, a_im, bu_re, bu_im), axis=1)
    y = (jnp.einsum('btgn,gpn->btgp', s_re, c_re.astype(f32))
         - jnp.einsum('btgn,gpn->btgp', s_im, c_im.astype(f32))
         + d_skip.astype(f32) * uf)
    y = jax.nn.gelu(y.reshape(bsz, t_len, SSM_WIDTH))
    y = y * jax.nn.sigmoid(y @ glu_w.astype(f32) + glu_b.astype(f32))
    return y.astype(u.dtype)


def _clamped_swiglu(h):
    x_glu = jnp.minimum(h[..., ::2], SWIGLU_LIMIT)
    x_lin = jnp.clip(h[..., 1::2], -SWIGLU_LIMIT, SWIGLU_LIMIT)
    return x_glu * jax.nn.sigmoid(SWIGLU_ALPHA * x_glu) * (x_lin + 1.0)


def _moe(h, router_w, router_b, w1, b1, w2, b2):
    bsz, t_len, d = h.shape
    xt = h.reshape(-1, d)
    m = xt.shape[0]
    logits = (xt @ router_w + router_b).astype(jnp.float32)
    top_val, top_idx = lax.top_k(logits, TOP_K)
    gate = jax.nn.softmax(top_val, axis=-1).astype(h.dtype)
    n_assign = m * TOP_K
    n_slots = ((n_assign + N_EXPERTS * (MOE_BLOCK - 1)) + MOE_BLOCK - 1) // MOE_BLOCK * MOE_BLOCK
    n_blocks = n_slots // MOE_BLOCK
    flat_e = top_idx.reshape(-1)
    flat_tok = jnp.arange(n_assign, dtype=jnp.int32) // TOP_K
    flat_w = gate.reshape(-1)
    order = jnp.argsort(flat_e)
    sorted_e, sorted_tok, sorted_w = flat_e[order], flat_tok[order], flat_w[order]
    counts = jnp.bincount(flat_e, length=N_EXPERTS)
    padded = (counts + MOE_BLOCK - 1) // MOE_BLOCK * MOE_BLOCK
    pad_end = jnp.cumsum(padded)
    pad_start = pad_end - padded
    start = jnp.cumsum(counts) - counts
    dest = pad_start[sorted_e] + (jnp.arange(n_assign, dtype=jnp.int32) - start[sorted_e])
    slot_tok = jnp.zeros((n_slots,), jnp.int32).at[dest].set(sorted_tok)
    slot_w = jnp.zeros((n_slots,), h.dtype).at[dest].set(sorted_w)
    blk_e = jnp.minimum(
        jnp.searchsorted(pad_end, jnp.arange(n_blocks, dtype=jnp.int32) * MOE_BLOCK, side='right'),
        N_EXPERTS - 1)
    xs = xt[slot_tok].reshape(n_blocks, MOE_BLOCK, d)

    def expert_block(args):
        xb, e = args
        act = _clamped_swiglu(xb @ w1[e] + b1[e])
        return act @ w2[e] + b2[e]

    ys = lax.map(expert_block, (xs, blk_e)).reshape(n_slots, d) * slot_w[:, None]
    out = jax.ops.segment_sum(ys, slot_tok, num_segments=m)
    return out.reshape(bsz, t_len, d)


def setup_inputs(seed: int = 0) -> dict:
    key = jax.random.key(seed)
    ks = jax.random.split(key, 32)
    f32 = jnp.float32
    L = DEPTH

    def nrm(k, shape, scale):
        return jax.random.normal(k, shape, f32) * scale

    x = jax.random.normal(ks[0], (BATCH, SEQ, D_MODEL), f32)
    norm_mix_g = 1.0 + nrm(ks[1], (L, D_MODEL), 0.02)
    w_in = nrm(ks[2], (L, D_MODEL, IN_PROJ_WIDTH), D_MODEL ** -0.5)
    b_gate = nrm(ks[3], (L, 2 * D_MODEL), 0.02)
    pool_w = nrm(ks[4], (L, POOL_GROUPS, POOL_GROUP_DIM, POOL_GROUP_DIM), POOL_GROUP_DIM ** -0.5)
    pool_scale = 1.0 + nrm(ks[5], (L, POOL_WIDTH), 0.1)
    n_idx = jnp.arange(SSM_STATE, dtype=f32)
    ssm_lambda_re = -0.5 + nrm(ks[6], (L, SSM_GROUPS, SSM_STATE), 0.01)
    ssm_lambda_im = math.pi * n_idx + nrm(ks[7], (L, SSM_GROUPS, SSM_STATE), 0.01)
    ssm_log_dt = jax.random.uniform(ks[8], (L, SSM_GROUPS), f32, math.log(DT_MIN), math.log(DT_MAX))
    b_scale = (2.0 * SSM_GROUP_DIM) ** -0.5
    ssm_b_re = nrm(ks[9], (L, SSM_GROUPS, SSM_STATE, SSM_GROUP_DIM), b_scale)
    ssm_b_im = nrm(ks[10], (L, SSM_GROUPS, SSM_STATE, SSM_GROUP_DIM), b_scale)
    c_scale = (2.0 * SSM_STATE) ** -0.5
    ssm_c_re = nrm(ks[11], (L, SSM_GROUPS, SSM_GROUP_DIM, SSM_STATE), c_scale)
    ssm_c_im = nrm(ks[12], (L, SSM_GROUPS, SSM_GROUP_DIM, SSM_STATE), c_scale)
    ssm_d = nrm(ks[13], (L, SSM_GROUPS, SSM_GROUP_DIM), 1.0)
    ssm_glu_w = nrm(ks[14], (L, SSM_WIDTH, SSM_WIDTH), SSM_WIDTH ** -0.5)
    ssm_glu_b = nrm(ks[15], (L, SSM_WIDTH), 0.02)
    w_pool_up = nrm(ks[16], (L, POOL_WIDTH, D_MODEL), POOL_WIDTH ** -0.5)
    w_ssm_up = nrm(ks[17], (L, SSM_WIDTH, D_MODEL), SSM_WIDTH ** -0.5)
    w_out = nrm(ks[18], (L, D_MODEL, D_MODEL), D_MODEL ** -0.5)
    norm_ffn_g = 1.0 + nrm(ks[19], (L, D_MODEL), 0.02)
    router_w = nrm(ks[20], (L, D_MODEL, N_EXPERTS), D_MODEL ** -0.5)
    router_b = nrm(ks[21], (L, N_EXPERTS), 0.01)
    moe_w1 = nrm(ks[22], (L, N_EXPERTS, D_MODEL, 2 * D_FF), D_MODEL ** -0.5)
    moe_b1 = nrm(ks[23], (L, N_EXPERTS, 2 * D_FF), 0.02)
    moe_w2 = nrm(ks[24], (L, N_EXPERTS, D_FF, D_MODEL), D_FF ** -0.5)
    moe_b2 = nrm(ks[25], (L, N_EXPERTS, D_MODEL), 0.02)
    norm_final_g = 1.0 + nrm(ks[26], (D_MODEL,), 0.02)
    return {
        "x": x, "norm_mix_g": norm_mix_g, "w_in": w_in, "b_gate": b_gate,
        "pool_w": pool_w, "pool_scale": pool_scale,
        "ssm_lambda_re": ssm_lambda_re, "ssm_lambda_im": ssm_lambda_im, "ssm_log_dt": ssm_log_dt,
        "ssm_b_re": ssm_b_re, "ssm_b_im": ssm_b_im, "ssm_c_re": ssm_c_re, "ssm_c_im": ssm_c_im,
        "ssm_d": ssm_d, "ssm_glu_w": ssm_glu_w, "ssm_glu_b": ssm_glu_b,
        "w_pool_up": w_pool_up, "w_ssm_up": w_ssm_up, "w_out": w_out,
        "norm_ffn_g": norm_ffn_g, "router_w": router_w, "router_b": router_b,
        "moe_w1": moe_w1, "moe_b1": moe_b1, "moe_w2": moe_w2, "moe_b2": moe_b2,
        "norm_final_g": norm_final_g,
    }


def reference(x, norm_mix_g, w_in, b_gate, pool_w, pool_scale,
              ssm_lambda_re, ssm_lambda_im, ssm_log_dt, ssm_b_re, ssm_b_im, ssm_c_re, ssm_c_im,
              ssm_d, ssm_glu_w, ssm_glu_b, w_pool_up, w_ssm_up, w_out,
              norm_ffn_g, router_w, router_b, moe_w1, moe_b1, moe_w2, moe_b2,
              norm_final_g):
    for l in range(DEPTH):
        h = _rmsnorm(x, norm_mix_g[l])
        proj = h @ w_in[l]
        u_pool = proj[..., :POOL_WIDTH]
        u_ssm = proj[..., POOL_WIDTH:MIX_WIDTH]
        gates = jax.nn.sigmoid(proj[..., MIX_WIDTH:] + b_gate[l])
        g_pool, g_ssm = gates[..., :D_MODEL], gates[..., D_MODEL:]
        y_pool = _pool_mixer(u_pool, pool_w[l], pool_scale[l]) @ w_pool_up[l]
        y_ssm = _ssm_mixer(u_ssm, ssm_lambda_re[l], ssm_lambda_im[l], ssm_log_dt[l],
                           ssm_b_re[l], ssm_b_im[l], ssm_c_re[l], ssm_c_im[l],
                           ssm_d[l], ssm_glu_w[l], ssm_glu_b[l]) @ w_ssm_up[l]
        x = x + (g_pool * y_pool + g_ssm * y_ssm) @ w_out[l]
        x = x + _moe(_rmsnorm(x, norm_ffn_g[l]), router_w[l], router_b[l],
                     moe_w1[l], moe_b1[l], moe_w2[l], moe_b2[l])
    return _rmsnorm(x, norm_final_g)
```

```cpp
#include <hip/hip_runtime.h>
#include <cstdio>
#include <cstdint>
namespace nv {
constexpr int D = 1024, T = 4096, NB = 8, MTOK = NB * T, E = 32, FF = 1024;
constexpr int MT = 4096;

__device__ __forceinline__ float wsum(float v) {
#pragma unroll
    for (int o = 1; o < 64; o <<= 1) v += __shfl_xor(v, o);
    return v;
}
__device__ __forceinline__ float sigm(float x) { return 1.f / (1.f + __expf(-x)); }
__device__ __forceinline__ float gelu_tanh(float y) {
    const float k = 0.7978845608028654f;
    float u = k * (y + 0.044715f * y * y * y);
    return 0.5f * y * (1.f + tanhf(u));
}

__global__ void rmsnorm(const float* __restrict__ x, const float* __restrict__ g, float* __restrict__ y, int rows) {
    int row = blockIdx.x * 4 + (threadIdx.x >> 6), lane = threadIdx.x & 63;
    if (row >= rows) return;
    const float4* xr = (const float4*)(x + (size_t)row * D);
    float4 v[4]; float s = 0.f;
#pragma unroll
    for (int j = 0; j < 4; ++j) { v[j] = xr[lane + 64 * j]; s += v[j].x * v[j].x + v[j].y * v[j].y + v[j].z * v[j].z + v[j].w * v[j].w; }
    s = wsum(s);
    float r = rsqrtf(s * (1.f / D) + 1e-6f);
    float4* yr = (float4*)(y + (size_t)row * D);
    const float4* gr = (const float4*)g;
#pragma unroll
    for (int j = 0; j < 4; ++j) { float4 gg = gr[lane + 64 * j]; float4 o; o.x = v[j].x * r * gg.x; o.y = v[j].y * r * gg.y; o.z = v[j].z * r * gg.z; o.w = v[j].w * r * gg.w; yr[lane + 64 * j] = o; }
}

template <bool GATHER>
__global__ void __launch_bounds__(256) sgemm(const float* __restrict__ A, int lda, const float* __restrict__ B, int ldb, float* __restrict__ C, int ldc,
                                             int M, int N, int K, const int* __restrict__ rowidx, const int* __restrict__ cnt, const int* __restrict__ off, size_t strideB, int cap) {
    __shared__ float As[16][68];
    __shared__ float Bs[16][68];
    const int z = blockIdx.z;
    int Mloc = M, rowbase = 0;
    if (cnt) { Mloc = cnt[z]; rowbase = off[z]; }
    const int m0 = blockIdx.y * 64, n0 = blockIdx.x * 64;
    if (m0 >= Mloc) return;
    B += (size_t)z * strideB;
    const int tid = threadIdx.x, tx = tid & 15, ty = tid >> 4;
    const int ar = tid >> 2, ak = (tid & 3) * 4;
    const int grow = m0 + ar; const bool av = grow < Mloc;
    const float* ap = A;
    if (av) { int src = GATHER ? rowidx[z * cap + grow] : (rowbase + grow); ap = A + (size_t)src * lda; }
    const int bk = tid >> 4, bn = (tid & 15) * 4;
    float acc00 = 0, acc01 = 0, acc02 = 0, acc03 = 0, acc10 = 0, acc11 = 0, acc12 = 0, acc13 = 0, acc20 = 0, acc21 = 0, acc22 = 0, acc23 = 0, acc30 = 0, acc31 = 0, acc32 = 0, acc33 = 0;
    for (int k0 = 0; k0 < K; k0 += 16) {
        float4 a = av ? *(const float4*)(ap + k0 + ak) : make_float4(0.f, 0.f, 0.f, 0.f);
        As[ak + 0][ar] = a.x; As[ak + 1][ar] = a.y; As[ak + 2][ar] = a.z; As[ak + 3][ar] = a.w;
        float4 b = *(const float4*)(B + (size_t)(k0 + bk) * ldb + n0 + bn);
        *(float4*)&Bs[bk][bn] = b;
        __syncthreads();
#pragma unroll
        for (int kk = 0; kk < 16; ++kk) {
            float4 a4 = *(const float4*)&As[kk][ty * 4];
            float4 b4 = *(const float4*)&Bs[kk][tx * 4];
            acc00 += a4.x * b4.x; acc01 += a4.x * b4.y; acc02 += a4.x * b4.z; acc03 += a4.x * b4.w;
            acc10 += a4.y * b4.x; acc11 += a4.y * b4.y; acc12 += a4.y * b4.z; acc13 += a4.y * b4.w;
            acc20 += a4.z * b4.x; acc21 += a4.z * b4.y; acc22 += a4.z * b4.z; acc23 += a4.z * b4.w;
            acc30 += a4.w * b4.x; acc31 += a4.w * b4.y; acc32 += a4.w * b4.z; acc33 += a4.w * b4.w;
        }
        __syncthreads();
    }
    const int r0 = m0 + ty * 4, c0 = n0 + tx * 4;
    if (r0 + 0 < Mloc) *(float4*)(C + (size_t)(rowbase + r0 + 0) * ldc + c0) = make_float4(acc00, acc01, acc02, acc03);
    if (r0 + 1 < Mloc) *(float4*)(C + (size_t)(rowbase + r0 + 1) * ldc + c0) = make_float4(acc10, acc11, acc12, acc13);
    if (r0 + 2 < Mloc) *(float4*)(C + (size_t)(rowbase + r0 + 2) * ldc + c0) = make_float4(acc20, acc21, acc22, acc23);
    if (r0 + 3 < Mloc) *(float4*)(C + (size_t)(rowbase + r0 + 3) * ldc + c0) = make_float4(acc30, acc31, acc32, acc33);
}

__global__ void pool_diff(const float* __restrict__ proj, float* __restrict__ d) {
    int i = blockIdx.x * blockDim.x + threadIdx.x;
    if (i >= T * 512) return;
    int t = i >> 9, c = i & 511, g = c >> 7;
    int w = 2 << g;
    int n = (t + 1 < w) ? (t + 1) : w;
    float s = 0.f;
    for (int j = 0; j < n; ++j) s += proj[(size_t)(t - j) * 3072 + c];
    d[i] = s / (float)n - proj[(size_t)t * 3072 + c];
}
__global__ void scale_cols(float* __restrict__ y, const float* __restrict__ sc, int n, int ncols) {
    int i = blockIdx.x * blockDim.x + threadIdx.x; if (i >= n) return; y[i] *= sc[i % ncols];
}

__global__ void __launch_bounds__(64) ssm_scan(const float* __restrict__ proj, const float* __restrict__ lam_re, const float* __restrict__ lam_im, const float* __restrict__ log_dt,
                                               const float* __restrict__ b_re, const float* __restrict__ b_im, const float* __restrict__ c_re, const float* __restrict__ c_im,
                                               const float* __restrict__ dsk, float* __restrict__ yg) {
    const int g = blockIdx.x, n = threadIdx.x;
    const float lr = lam_re[g * 64 + n], li = lam_im[g * 64 + n], dt = __expf(log_dt[g]);
    const float mag = expf(lr * dt);
    const float lbr = mag * cosf(li * dt), lbi = mag * sinf(li * dt);
    const float den = lr * lr + li * li, xr = lbr - 1.f, xi = lbi;
    const float fr = (xr * lr + xi * li) / den, fi = (xi * lr - xr * li) / den;
    float bbr[16], bbi[16], cr[16], ci[16];
#pragma unroll
    for (int q = 0; q < 16; ++q) {
        float br = b_re[(g * 64 + n) * 16 + q], bi = b_im[(g * 64 + n) * 16 + q];
        bbr[q] = fr * br - fi * bi; bbi[q] = fr * bi + fi * br;
        cr[q] = c_re[(g * 16 + q) * 64 + n]; ci[q] = c_im[(g * 16 + q) * 64 + n];
    }
    const float dmy = (n < 16) ? dsk[g * 16 + n] : 0.f;
    float sr = 0.f, si = 0.f;
    for (int t = 0; t < T; ++t) {
        const float* up = proj + (size_t)t * 3072 + 512 + g * 16;
        float ur = 0.f, ui = 0.f, myu = 0.f;
#pragma unroll
        for (int q = 0; q < 16; ++q) { float u = up[q]; ur += bbr[q] * u; ui += bbi[q] * u; myu = (n == q) ? u : myu; }
        float nr = lbr * sr - lbi * si + ur, ni = lbr * si + lbi * sr + ui;
        sr = nr; si = ni;
        float myy = 0.f;
#pragma unroll
        for (int p = 0; p < 16; ++p) { float v = wsum(cr[p] * sr - ci[p] * si); myy = (n == p) ? v : myy; }
        if (n < 16) yg[(size_t)t * 512 + g * 16 + n] = gelu_tanh(myy + dmy * myu);
    }
}
__global__ void glu_gate(const float* __restrict__ yg, const float* __restrict__ z, const float* __restrict__ b, float* __restrict__ ys, int n) {
    int i = blockIdx.x * blockDim.x + threadIdx.x; if (i >= n) return; ys[i] = yg[i] * sigm(z[i] + b[i & 511]);
}
__global__ void merge_gates(const float* __restrict__ proj, const float* __restrict__ bg, const float* __restrict__ yp, const float* __restrict__ ysm, float* __restrict__ mg, int n) {
    int i = blockIdx.x * blockDim.x + threadIdx.x; if (i >= n) return; int t = i >> 10, c = i & 1023;
    float g1 = sigm(proj[(size_t)t * 3072 + 1024 + c] + bg[c]), g2 = sigm(proj[(size_t)t * 3072 + 2048 + c] + bg[1024 + c]);
    mg[i] = g1 * yp[i] + g2 * ysm[i];
}
__global__ void add_res(const float* __restrict__ x, const float* __restrict__ y, float* __restrict__ o, int n) {
    int i = blockIdx.x * blockDim.x + threadIdx.x; if (i >= n) return; o[i] = x[i] + y[i];
}
__global__ void router(const float* __restrict__ h2, const float* __restrict__ rw, const float* __restrict__ rb, int ntok,
                       int* __restrict__ cnt, int* __restrict__ lists, int cap, int* __restrict__ tok_e, int* __restrict__ tok_pos, float* __restrict__ tok_g) {
    int tok = blockIdx.x * 4 + (threadIdx.x >> 6), lane = threadIdx.x & 63;
    if (tok >= ntok) return;
    int e = lane & 31, hh = lane >> 5;
    const float* hr = h2 + (size_t)tok * D + hh * 512;
    const float* wr = rw + (size_t)hh * 512 * E + e;
    float s = 0.f;
    for (int k = 0; k < 512; ++k) s += hr[k] * wr[(size_t)k * E];
    s += __shfl_xor(s, 32);
    s += rb[e];
    float v = s; int sel_e[4]; float sel_v[4];
#pragma unroll
    for (int k = 0; k < 4; ++k) {
        float best = v; int bi = e;
#pragma unroll
        for (int o = 1; o < 32; o <<= 1) { float ov = __shfl_xor(best, o); int oi = __shfl_xor(bi, o); if (ov > best || (ov == best && oi < bi)) { best = ov; bi = oi; } }
        sel_e[k] = bi; sel_v[k] = best;
        if (e == bi) v = -3.0e38f;
    }
    float mx = sel_v[0];
    float e0 = __expf(sel_v[0] - mx), e1 = __expf(sel_v[1] - mx), e2 = __expf(sel_v[2] - mx), e3 = __expf(sel_v[3] - mx);
    float inv = 1.f / (e0 + e1 + e2 + e3);
    if (lane < 4) {
        int ee = lane == 0 ? sel_e[0] : lane == 1 ? sel_e[1] : lane == 2 ? sel_e[2] : sel_e[3];
        float gg = (lane == 0 ? e0 : lane == 1 ? e1 : lane == 2 ? e2 : e3) * inv;
        int pos = atomicAdd(&cnt[ee], 1);
        lists[ee * cap + pos] = tok;
        tok_e[tok * 4 + lane] = ee; tok_pos[tok * 4 + lane] = pos; tok_g[tok * 4 + lane] = gg;
    }
}
__global__ void zero_i(int* p, int n) { int i = blockIdx.x * blockDim.x + threadIdx.x; if (i < n) p[i] = 0; }
__global__ void offsets(const int* __restrict__ cnt, int* __restrict__ off) { if (threadIdx.x == 0) { int s = 0; for (int e = 0; e < E; ++e) { off[e] = s; s += cnt[e]; } } }
__global__ void swiglu(const float* __restrict__ h, const float* __restrict__ b1, const int* __restrict__ cnt, const int* __restrict__ off, float* __restrict__ act) {
    int e = blockIdx.z; int r = blockIdx.y; if (r >= cnt[e]) return; int row = off[e] + r;
    int j = blockIdx.x * blockDim.x + threadIdx.x;
    float a = h[(size_t)row * 2048 + 2 * j] + b1[e * 2048 + 2 * j], l = h[(size_t)row * 2048 + 2 * j + 1] + b1[e * 2048 + 2 * j + 1];
    a = fminf(a, 7.f); l = fminf(fmaxf(l, -7.f), 7.f);
    act[(size_t)row * FF + j] = a * sigm(1.702f * a) * (l + 1.f);
}
__global__ void combine_final(const float* __restrict__ x1, const float* __restrict__ y2, const float* __restrict__ b2, const int* __restrict__ off, const int* __restrict__ tok_e,
                              const int* __restrict__ tok_pos, const float* __restrict__ tok_g, const float* __restrict__ gf, float* __restrict__ out, int ntok) {
    int tok = blockIdx.x * 4 + (threadIdx.x >> 6), lane = threadIdx.x & 63;
    if (tok >= ntok) return;
    float4 v[4];
    const float4* xr = (const float4*)(x1 + (size_t)tok * D);
#pragma unroll
    for (int j = 0; j < 4; ++j) v[j] = xr[lane + 64 * j];
#pragma unroll
    for (int k = 0; k < 4; ++k) {
        int e = tok_e[tok * 4 + k]; int row = off[e] + tok_pos[tok * 4 + k]; float g = tok_g[tok * 4 + k];
        const float4* yr = (const float4*)(y2 + (size_t)row * D); const float4* br = (const float4*)(b2 + (size_t)e * D);
#pragma unroll
        for (int j = 0; j < 4; ++j) { float4 y = yr[lane + 64 * j], b = br[lane + 64 * j]; v[j].x += g * (y.x + b.x); v[j].y += g * (y.y + b.y); v[j].z += g * (y.z + b.z); v[j].w += g * (y.w + b.w); }
    }
    float s = 0.f;
#pragma unroll
    for (int j = 0; j < 4; ++j) s += v[j].x * v[j].x + v[j].y * v[j].y + v[j].z * v[j].z + v[j].w * v[j].w;
    s = wsum(s);
    float r = rsqrtf(s * (1.f / D) + 1e-6f);
    float4* orow = (float4*)(out + (size_t)tok * D); const float4* gr = (const float4*)gf;
#pragma unroll
    for (int j = 0; j < 4; ++j) { float4 gg = gr[lane + 64 * j]; orow[lane + 64 * j] = make_float4(v[j].x * r * gg.x, v[j].y * r * gg.y, v[j].z * r * gg.z, v[j].w * r * gg.w); }
}

struct In {
    const float *x, *norm_mix_g, *w_in, *b_gate, *pool_w, *pool_scale, *lam_re, *lam_im, *log_dt, *b_re, *b_im, *c_re, *c_im, *ssm_d, *glu_w, *glu_b,
        *w_pool_up, *w_ssm_up, *w_out, *norm_ffn_g, *router_w, *router_b, *w1, *b1, *w2, *b2, *norm_final_g;
};

static void forward(const In& I, float* out, unsigned char* ws, hipStream_t st, int nbatch = NB) {
    size_t o = 0;
    auto take = [&](size_t bytes) { unsigned char* p = ws + o; o += (bytes + 255) & ~(size_t)255; return p; };
    float* x1 = (float*)take((size_t)MTOK * D * 4);
    float* nh = (float*)take((size_t)MT * D * 4);
    float* nproj = (float*)take((size_t)MT * 3072 * 4);
    float* ndd = (float*)take((size_t)MT * 512 * 4);
    float* nyp1 = (float*)take((size_t)MT * 512 * 4);
    float* nypool = (float*)take((size_t)MT * D * 4);
    float* nyg = (float*)take((size_t)MT * 512 * 4);
    float* nz = (float*)take((size_t)MT * 512 * 4);
    float* nys = (float*)take((size_t)MT * 512 * 4);
    float* nyssm = (float*)take((size_t)MT * D * 4);
    float* nmg = (float*)take((size_t)MT * D * 4);
    float* nmo = (float*)take((size_t)MT * D * 4);
    int* cnt = (int*)take(256); int* off = (int*)take(256);
    int* lists = (int*)take((size_t)E * MT * 4);
    int* tok_e = (int*)take((size_t)MT * 4 * 4); int* tok_pos = (int*)take((size_t)MT * 4 * 4); float* tok_g = (float*)take((size_t)MT * 4 * 4);
    float* hbuf = (float*)take((size_t)MT * 4 * 2048 * 4);
    float* act = (float*)take((size_t)MT * 4 * FF * 4);
    float* y2 = (float*)take((size_t)MT * 4 * D * 4);
    for (int b = 0; b < nbatch; ++b) {
        const float* xb = I.x + (size_t)b * MT * D; float* x1b = x1 + (size_t)b * MT * D;
        rmsnorm<<<MT / 4, 256, 0, st>>>(xb, I.norm_mix_g, nh, MT);
        sgemm<false><<<dim3(3072 / 64, MT / 64, 1), 256, 0, st>>>(nh, D, I.w_in, 3072, nproj, 3072, MT, 3072, D, nullptr, nullptr, nullptr, 0, 0);
        pool_diff<<<MT * 512 / 256, 256, 0, st>>>(nproj, ndd);
        for (int g = 0; g < 4; ++g)
            sgemm<false><<<dim3(128 / 64, MT / 64, 1), 256, 0, st>>>(ndd + g * 128, 512, I.pool_w + (size_t)g * 128 * 128, 128, nyp1 + g * 128, 512, MT, 128, 128, nullptr, nullptr, nullptr, 0, 0);
        scale_cols<<<MT * 512 / 256, 256, 0, st>>>(nyp1, I.pool_scale, MT * 512, 512);
        sgemm<false><<<dim3(D / 64, MT / 64, 1), 256, 0, st>>>(nyp1, 512, I.w_pool_up, D, nypool, D, MT, D, 512, nullptr, nullptr, nullptr, 0, 0);
        ssm_scan<<<32, 64, 0, st>>>(nproj, I.lam_re, I.lam_im, I.log_dt, I.b_re, I.b_im, I.c_re, I.c_im, I.ssm_d, nyg);
        sgemm<false><<<dim3(512 / 64, MT / 64, 1), 256, 0, st>>>(nyg, 512, I.glu_w, 512, nz, 512, MT, 512, 512, nullptr, nullptr, nullptr, 0, 0);
        glu_gate<<<MT * 512 / 256, 256, 0, st>>>(nyg, nz, I.glu_b, nys, MT * 512);
        sgemm<false><<<dim3(D / 64, MT / 64, 1), 256, 0, st>>>(nys, 512, I.w_ssm_up, D, nyssm, D, MT, D, 512, nullptr, nullptr, nullptr, 0, 0);
        merge_gates<<<MT * D / 256, 256, 0, st>>>(nproj, I.b_gate, nypool, nyssm, nmg, MT * D);
        sgemm<false><<<dim3(D / 64, MT / 64, 1), 256, 0, st>>>(nmg, D, I.w_out, D, nmo, D, MT, D, D, nullptr, nullptr, nullptr, 0, 0);
        add_res<<<MT * D / 256, 256, 0, st>>>(xb, nmo, x1b, MT * D);
        rmsnorm<<<MT / 4, 256, 0, st>>>(x1b, I.norm_ffn_g, nh, MT);
        zero_i<<<1, 64, 0, st>>>(cnt, 64);
        router<<<MT / 4, 256, 0, st>>>(nh, I.router_w, I.router_b, MT, cnt, lists, MT, tok_e, tok_pos, tok_g);
        offsets<<<1, 64, 0, st>>>(cnt, off);
        sgemm<true><<<dim3(2048 / 64, MT / 64, E), 256, 0, st>>>(nh, D, I.w1, 2048, hbuf, 2048, MT, 2048, D, lists, cnt, off, (size_t)D * 2048, MT);
        swiglu<<<dim3(FF / 256, MT, E), 256, 0, st>>>(hbuf, I.b1, cnt, off, act);
        sgemm<false><<<dim3(D / 64, MT / 64, E), 256, 0, st>>>(act, FF, I.w2, D, y2, D, MT, D, FF, nullptr, cnt, off, (size_t)FF * D, MT);
        combine_final<<<MT / 4, 256, 0, st>>>(x1b, y2, I.b2, off, tok_e, tok_pos, tok_g, I.norm_final_g, out + (size_t)b * MT * D, MT);
    }
}
}
extern "C" void kernel_launch(void* const* d_in, const int* in_sizes, int n_in, void* d_out, int out_size, void* d_ws, size_t ws_size, hipStream_t stream) {
    if (n_in != 27 || out_size != nv::MTOK * nv::D || ws_size < ((size_t)800 << 20)) { fprintf(stderr, "kernel_launch: unexpected shapes n_in %d out %d ws %zu\n", n_in, out_size, ws_size); return; }
    nv::In I;
    const float** p = (const float**)&I;
    for (int i = 0; i < 27; ++i) p[i] = (const float*)d_in[i];
    nv::forward(I, (float*)d_out, (unsigned char*)d_ws, stream);
}
```

```cpp
#define MK_SINGLE 0
#include <hip/hip_runtime.h>
#include <cstdio>
#include <cstdint>
namespace mk {
#define LAS __attribute__((address_space(3)))
#define GAS __attribute__((address_space(1)))
typedef unsigned short bf16_t;
typedef short bf16x8 __attribute__((ext_vector_type(8)));
typedef float f32x4 __attribute__((ext_vector_type(4)));
typedef float f32x2 __attribute__((ext_vector_type(2)));
typedef unsigned u32x4 __attribute__((ext_vector_type(4)));
typedef unsigned u32x2 __attribute__((ext_vector_type(2)));

constexpr int D = 1024, T = 4096, NB = 8, M = NB * T, E = 32, FF = 1024;
constexpr int NG = 32, LCH = 64, NCH = M / LCH  , KCAT = 128 + LCH * 16  ;
constexpr int NWAVES = 8, NTHR = 512;
constexpr int BM = 256, BK = 64, HALF = 128, HTB = HALF * BK * 2, STAGE_BYTES = 8 * HTB, NXCD = 8, WGM = 8;

__device__ __forceinline__ unsigned f2bf(float f) { unsigned u = __builtin_bit_cast(unsigned, f); return (u + 0x7fffu + ((u >> 16) & 1u)) >> 16; }
__device__ __forceinline__ unsigned pk2(float lo, float hi) { return f2bf(lo) | (f2bf(hi) << 16); }
__device__ __forceinline__ float bf2f(unsigned h) { return __builtin_bit_cast(float, h << 16); }
__device__ __forceinline__ float bflo(unsigned w) { return __builtin_bit_cast(float, w << 16); }
__device__ __forceinline__ float bfhi(unsigned w) { return __builtin_bit_cast(float, w & 0xffff0000u); }
__device__ __forceinline__ unsigned cvt_pk_bf16(float lo, float hi) { unsigned r; asm volatile("v_cvt_pk_bf16_f32 %0, %1, %2" : "=v"(r) : "v"(lo), "v"(hi)); return r; }
__device__ __forceinline__ float wave_sum(float v) {
#pragma unroll
    for (int o = 1; o < 64; o <<= 1) v += __shfl_xor(v, o);
    return v;
}
__device__ __forceinline__ float sigm(float x) { return __builtin_amdgcn_rcpf(1.f + __expf(-x)); }
__device__ __forceinline__ float gelu_tanh(float y) {
    const float u = 0.7978845608028654f * (y + 0.044715f * y * y * y);
    return y * sigm(2.f * u);
}
#define LDS_WAIT() asm volatile("s_waitcnt lgkmcnt(0)" ::: "memory")
#define VM_WAIT() asm volatile("s_waitcnt vmcnt(0)" ::: "memory")

#define XB_TMO      128
#define XB_XCNT(j)  (256  + 64 * (j))
#define XB_XSUB(j)  (1280 + 64 * (j))
#define XB_XGEN(j)  (2304 + 64 * (j))
#define XB_TOP      3328
#define XB_TOPGEN   3392
#define XCD_BAR_WORDS 3456
#define XB_SPIN_CAP (1u << 20)
__device__ __forceinline__ unsigned xb_ld(unsigned* p)              { return __hip_atomic_load(p, __ATOMIC_RELAXED, __HIP_MEMORY_SCOPE_AGENT); }
__device__ __forceinline__ unsigned xb_add(unsigned* p, unsigned v) { return __hip_atomic_fetch_add(p, v, __ATOMIC_RELAXED, __HIP_MEMORY_SCOPE_AGENT); }
__device__ __forceinline__ unsigned xb_xcc_id() { return (unsigned)__builtin_amdgcn_s_getreg((3 << 11) | 20) & 0xFu; }
#define XB_SPIN(cond, bar) do { unsigned _sp = 0; while (cond) { __builtin_amdgcn_s_sleep(1); \
    if ((++_sp & 255u) == 0u) { if (xb_ld(&(bar)[XB_TMO])) break; if (_sp > XB_SPIN_CAP) { atomicAdd(&(bar)[XB_TMO], 1u); break; } } } } while (0)
struct XcdBarrier { unsigned* bar; unsigned x; volatile LAS unsigned* st; };
__device__ __forceinline__ XcdBarrier xcd_barrier_post(unsigned* bar, volatile LAS unsigned* st) {
    XcdBarrier b; b.bar = bar; b.x = xb_xcc_id(); b.st = st;
    if (threadIdx.x == 0) (void)xb_add(&bar[XB_XCNT(b.x)], 1u);
    return b;
}
__device__ __forceinline__ void xcd_barrier_complete(unsigned* bar, unsigned x, unsigned& nloc, unsigned& nx) {
    const unsigned G = gridDim.x * gridDim.y * gridDim.z;
    unsigned sum, cnt, mine, sp = 0u;
    for (;;) {
        sum = 0u; cnt = 0u; mine = 0u;
#pragma unroll
        for (unsigned j = 0; j < 16; ++j) { const unsigned c = xb_ld(&bar[XB_XCNT(j)]); sum += c; cnt += (c > 0u) ? 1u : 0u; mine = (j == x) ? c : mine; }
        if (sum == G) break;
        __builtin_amdgcn_s_sleep(1);
        if ((++sp & 255u) == 0u) { if (xb_ld(&bar[XB_TMO])) break; if (sp > XB_SPIN_CAP) { atomicAdd(&bar[XB_TMO], 1u); break; } }
    }
    nloc = mine > 0u ? mine : 1u; nx = cnt > 0u ? cnt : 1u;
}
__device__ __forceinline__ void xcd_barrier(const XcdBarrier& b) {
    asm volatile("s_waitcnt vmcnt(0)" ::: "memory");
    __syncthreads();
    if (threadIdx.x == 0) {
        unsigned* bar = b.bar;
        __builtin_amdgcn_s_waitcnt(0);
        unsigned nloc = b.st[0], nx = b.st[1];
        if (nloc == 0u) { xcd_barrier_complete(bar, b.x, nloc, nx); b.st[0] = nloc; b.st[1] = nx; }
        const unsigned old = xb_add(&bar[XB_XSUB(b.x)], 1u);
        const unsigned gen = old / nloc;
        if (old + 1u == (gen + 1u) * nloc) {
            __builtin_amdgcn_fence(__ATOMIC_RELEASE, "agent");
            asm volatile("s_waitcnt vmcnt(0)" ::: "memory");
            const unsigned og = xb_add(&bar[XB_TOP], 1u);
            const unsigned tg = og / nx;
            if (og + 1u == (tg + 1u) * nx) xb_add(&bar[XB_TOPGEN], 1u);
            else XB_SPIN(xb_ld(&bar[XB_TOPGEN]) == tg, bar);
            __builtin_amdgcn_fence(__ATOMIC_ACQUIRE, "agent");
            xb_add(&bar[XB_XGEN(b.x)], 1u);
            asm volatile("s_waitcnt vmcnt(0)" ::: "memory");
        } else {
            XB_SPIN(xb_ld(&bar[XB_XGEN(b.x)]) == gen, bar);
            __builtin_amdgcn_fence(__ATOMIC_ACQUIRE, "agent");
            asm volatile("s_waitcnt vmcnt(0)" ::: "memory");
        }
    }
    __syncthreads();
}

__device__ __forceinline__ int lds_byte(int r, int c) { const int st = (r >> 4) * 2 + (c >> 5), rr = r & 15, cc = c & 31, ob = rr * 64 + cc * 2; return st * 1024 + (ob ^ (((ob >> 9) & 1) << 5)); }
__device__ __forceinline__ void stage_rc(int b, int& R, int& C) { const int st = b / 1024, sb = b % 1024, swz = sb ^ (((sb >> 9) & 1) << 5); R = (st >> 1) * 16 + swz / 64; C = (st & 1) * 32 + (swz % 64) / 2; }
__device__ __forceinline__ int perm32(int rho) { const int n = rho >> 4, i = rho & 15; return 8 * (i >> 2) + 4 * n + (i & 3); }

struct Unit { const char* A; const char* B; int nt; int pm, pn, g, rows, rb; };

struct GridOrder {
    int nM, nN, nwg, G, c;
    __device__ void init(int nM_, int nN_, int G_, int c_) { nM = nM_; nN = nN_; nwg = nM * nN; G = G_; c = c_; }
    __device__ bool next(int i, int& pm, int& pn) const {
        const long L = (long)i * G + c; if (L >= nwg) return false;
        int wgid = (int)L; { const int q = nwg / NXCD, r = nwg % NXCD, xcd = wgid % NXCD, off = wgid / NXCD; wgid = (xcd < r ? xcd * (q + 1) : r * (q + 1) + (xcd - r) * q) + off; }
        const int nig = WGM * nN, gid = wgid / nig, fm = gid * WGM, gsz = (nM - fm) < WGM ? (nM - fm) : WGM;
        pm = fm + ((wgid % nig) % gsz); pn = (wgid % nig) / gsz; return true;
    }
};

template <class Epi, class Sched, bool GATHER>
__device__ __forceinline__ void gemm_phase(LAS unsigned char* lds, LAS int* idxl, const char* gbase, const unsigned lda, const unsigned ldb, const Sched& S, const Epi& E) {
    const int tid = threadIdx.x, wid = __builtin_amdgcn_readfirstlane(tid >> 6), lane = tid & 63, wr = wid >> 2, wc = wid & 3, fr = lane & 15, fq = lane >> 4;
    unsigned voffB[2], cvA0[2], cvA1[2]; int RR[2], CC[2];
#pragma unroll
    for (int i = 0; i < 2; ++i) { int R, C; stage_rc(tid * 16 + i * 8192, R, C); const int Rb = Epi::PERM ? ((R & ~31) + perm32(R & 31)) : R; RR[i] = R; CC[i] = C;
        voffB[i] = (unsigned)Rb * ldb + (unsigned)C * 2u; cvA0[i] = (unsigned)R * lda + (unsigned)C * 2u; cvA1[i] = cvA0[i] + 128u * lda; }
    const size_t kstep = (size_t)(BK * 2);
    const size_t hstepB = (size_t)HALF * ldb;
    const unsigned ldsw = (unsigned)wid * 1024u;
    const int aoff = lds_byte(wr * 64 + fr, fq * 8), boff = lds_byte(wc * 32 + fr, fq * 8);
#define PG8_SA(b, h) (((b) * 2 + (h)) * HTB)
#define PG8_SB(b, h) ((4 + (b) * 2 + (h)) * HTB)
#define PG8_STAGE(bufoff, gbase_, voff) do { _Pragma("unroll") for (int _i = 0; _i < 2; ++_i) \
        __builtin_amdgcn_global_load_lds((const unsigned*)((const char*)(gbase_) + (voff)[_i]), (LAS unsigned*)(lds + (bufoff) + ldsw + _i * 8192), 16, 0, 0); } while (0)
#define PG8_LDA(dst, b, h) do { _Pragma("unroll") for (int m = 0; m < 4; ++m) _Pragma("unroll") for (int k = 0; k < 2; ++k) dst[m][k] = *(const LAS bf16x8*)(lds + PG8_SA(b, h) + aoff + m * 2048 + k * 1024); } while (0)
#define PG8_LDB(dst, b, h) do { _Pragma("unroll") for (int n = 0; n < 2; ++n) _Pragma("unroll") for (int k = 0; k < 2; ++k) dst[n][k] = *(const LAS bf16x8*)(lds + PG8_SB(b, h) + boff + n * 2048 + k * 1024); } while (0)
#define PG8_MMA(ai, bj, At, Bt) do { __builtin_amdgcn_s_setprio(1); _Pragma("unroll") for (int m = 0; m < 4; ++m) _Pragma("unroll") for (int n = 0; n < 2; ++n) _Pragma("unroll") for (int k = 0; k < 2; ++k) \
        acc[ai][bj][m][n] = __builtin_amdgcn_mfma_f32_16x16x32_bf16(Bt[n][k], At[m][k], acc[ai][bj][m][n], 0, 0, 0); __builtin_amdgcn_s_setprio(0); } while (0)
#define PG8_WAIT_V(n) asm volatile("s_waitcnt vmcnt(" #n ")" ::: "memory")
#define PG8_WAIT_L(n) asm volatile("s_waitcnt lgkmcnt(" #n ")" ::: "memory")
#define PG8_BAR __builtin_amdgcn_s_barrier()
#define PG8_SCHED __builtin_amdgcn_sched_barrier(0)
    Unit cur, nxt; int ui = 0;
    if (!S.next(0, cur)) return;
    if constexpr (GATHER) {
        if (tid < 256) { idxl[tid] = S.row_off(cur, tid); Unit u1; if (S.next(1, u1)) idxl[256 + tid] = S.row_off(u1, tid); }
        VM_WAIT(); LDS_WAIT(); __syncthreads();
#pragma unroll
        for (int i = 0; i < 2; ++i) { cvA0[i] = (unsigned)idxl[RR[i]] + (unsigned)CC[i] * 2u; cvA1[i] = (unsigned)idxl[128 + RR[i]] + (unsigned)CC[i] * 2u; }
    }
    f32x4 acc[2][2][4][2];
#pragma unroll
    for (int a = 0; a < 2; ++a)
#pragma unroll
        for (int b = 0; b < 2; ++b)
#pragma unroll
            for (int m = 0; m < 4; ++m)
#pragma unroll
                for (int n = 0; n < 2; ++n) acc[a][b][m][n] = (f32x4){0.f, 0.f, 0.f, 0.f};
    bf16x8 At[4][2], B0[2][2], B1[2][2];
    const char* cA = GATHER ? gbase : cur.A; const char* cB = cur.B;
    PG8_STAGE(PG8_SB(0, 0), cB, voffB); PG8_STAGE(PG8_SB(0, 1), cB + hstepB, voffB); PG8_STAGE(PG8_SA(0, 0), cA, cvA0); PG8_STAGE(PG8_SA(0, 1), cA, cvA1);
    if (wr == 1) PG8_BAR;
    PG8_WAIT_V(2); PG8_BAR;
    PG8_STAGE(PG8_SB(1, 0), cB + kstep, voffB); PG8_STAGE(PG8_SA(1, 0), cA + kstep, cvA0); PG8_STAGE(PG8_SB(1, 1), cB + hstepB + kstep, voffB);
    PG8_WAIT_V(6); PG8_BAR;
    for (;;) {
        const bool has_next = S.next(ui + 1, nxt);
        const char* nA = has_next ? (GATHER ? gbase : nxt.A) : cA; const char* nB = has_next ? nxt.B : cB;
        const int nt = cur.nt;
        for (int t = 0; t < nt; t += 2) {
            const bool last = (t == nt - 2);
            const char* a1 = cA + (size_t)(t + 1) * kstep;
            const char* a2 = last ? nA : cA + (size_t)(t + 2) * kstep; const char* b2 = last ? nB : cB + (size_t)(t + 2) * kstep;
            const char* a3 = a2 + kstep; const char* b3 = b2 + kstep;
            PG8_LDB(B0, 0, 0); PG8_LDB(B1, 0, 1); PG8_SCHED; PG8_LDA(At, 0, 0); PG8_STAGE(PG8_SA(1, 1), a1, cvA1);
            if constexpr (GATHER) { if (last && has_next) { int t2 = tid; asm volatile("" : "+v"(t2));
#pragma unroll
                for (int i = 0; i < 2; ++i) { int R, C; stage_rc(t2 * 16 + i * 8192, R, C); cvA0[i] = (unsigned)idxl[((ui + 1) & 1) * 256 + R] + (unsigned)C * 2u; cvA1[i] = (unsigned)idxl[((ui + 1) & 1) * 256 + 128 + R] + (unsigned)C * 2u; } } }
            PG8_WAIT_V(8); PG8_WAIT_L(0); PG8_BAR; PG8_MMA(0, 0, At, B0); PG8_MMA(0, 1, At, B1); PG8_BAR; PG8_SCHED;
            PG8_LDA(At, 0, 1); PG8_STAGE(PG8_SB(0, 0), b2, voffB); PG8_STAGE(PG8_SB(0, 1), b2 + hstepB, voffB); PG8_STAGE(PG8_SA(0, 0), a2, cvA0);
            PG8_WAIT_V(8); PG8_WAIT_L(0); PG8_BAR; PG8_MMA(1, 0, At, B0); PG8_MMA(1, 1, At, B1); PG8_BAR; PG8_SCHED;
            PG8_LDB(B0, 1, 0); PG8_LDB(B1, 1, 1); PG8_SCHED; PG8_LDA(At, 1, 0); PG8_STAGE(PG8_SA(0, 1), a2, cvA1);
            PG8_WAIT_V(8); PG8_WAIT_L(0); PG8_BAR; PG8_MMA(0, 0, At, B0); PG8_MMA(0, 1, At, B1); PG8_BAR; PG8_SCHED;
            PG8_LDA(At, 1, 1); PG8_STAGE(PG8_SB(1, 0), b3, voffB); PG8_STAGE(PG8_SB(1, 1), b3 + hstepB, voffB); PG8_STAGE(PG8_SA(1, 0), a3, cvA0);
            PG8_WAIT_V(8); PG8_WAIT_L(0); PG8_BAR; PG8_MMA(1, 0, At, B0); PG8_MMA(1, 1, At, B1); PG8_BAR; PG8_SCHED;
        }
        if (wr == 0) PG8_BAR;
        E(acc, cur, wr, wc, fr, fq);
        if constexpr (GATHER) {
            Unit u2; if (tid < 256 && S.next(ui + 2, u2)) idxl[(ui & 1) * 256 + tid] = S.row_off(u2, tid);
        }
        if (!has_next) break;
#pragma unroll
        for (int a = 0; a < 2; ++a)
#pragma unroll
            for (int b = 0; b < 2; ++b)
#pragma unroll
                for (int m = 0; m < 4; ++m)
#pragma unroll
                    for (int n = 0; n < 2; ++n) acc[a][b][m][n] = (f32x4){0.f, 0.f, 0.f, 0.f};
        cur = nxt; cA = nA; cB = nB; ++ui;
        if (wr == 1) PG8_BAR;
    }
    PG8_WAIT_V(0);
    PG8_BAR;
#undef PG8_SA
#undef PG8_SB
#undef PG8_STAGE
#undef PG8_LDA
#undef PG8_LDB
#undef PG8_MMA
#undef PG8_WAIT_V
#undef PG8_WAIT_L
#undef PG8_BAR
#undef PG8_SCHED
}
constexpr size_t MiB = 1u << 20;
constexpr size_t WS_CTL = 0;
constexpr size_t CTL_BYTES = 64 * 1024;
constexpr int CW_BAR = 1024;
constexpr int CW_CNT = 8192;
constexpr size_t WS_RSTD1 = 1 * MiB;
constexpr size_t WS_RSTD2 = WS_RSTD1 + (size_t)M * 4;
constexpr size_t WS_TOKE = WS_RSTD2 + (size_t)M * 4;
constexpr size_t WS_TOKP = WS_TOKE + (size_t)M * 16;
constexpr size_t WS_TOKG = WS_TOKP + (size_t)M * 16;
constexpr size_t WS_LISTS = WS_TOKG + (size_t)M * 16;
constexpr size_t WS_RWT = WS_LISTS + (size_t)E * M * 4;
constexpr size_t WS_B1P = WS_RWT + (size_t)E * D * 4;
constexpr size_t WS_LB64 = WS_B1P + (size_t)E * 2048 * 4;
constexpr size_t WS_KERN = WS_LB64 + (size_t)NG * 64 * 8;
constexpr size_t WS_SLOC = WS_KERN + (size_t)NG * 64 * 256 * 4;
constexpr size_t WS_SMALL_END = WS_SLOC + (size_t)NG * NCH * 128 * 4;
static_assert(WS_SMALL_END <= 24 * MiB, "small region");
constexpr size_t WS_WIN = 24 * MiB;
constexpr size_t WS_WCOMB = 30 * MiB;
constexpr size_t WS_GLU = 31 * MiB;
constexpr size_t WS_WSUP = 32 * MiB;
constexpr size_t WS_WOUT = 33 * MiB;
constexpr size_t WS_W2T = 36 * MiB;
constexpr size_t WS_X1 = 100 * MiB;
constexpr size_t WS_UPOOL = 228 * MiB;
constexpr size_t WS_DPOOL = 260 * MiB;
constexpr size_t WS_X1B = WS_UPOOL;
constexpr size_t WS_RA = 292 * MiB;
constexpr size_t WS_BCAT = WS_RA;
constexpr size_t WS_MST = WS_BCAT + (size_t)NG * 1024 * KCAT * 2;
constexpr size_t WS_YPG = WS_MST + (size_t)NG * 256 * 1024 * 2;
constexpr size_t WS_UCAT = WS_YPG + (size_t)M * D * 2;
constexpr size_t WS_YG = WS_UCAT + (size_t)NG * NCH * KCAT * 2;
constexpr size_t WS_YS = WS_YG + (size_t)M * 512 * 2;
constexpr size_t WS_RA_END = WS_YS + (size_t)M * 512 * 2;
constexpr size_t WS_ACT = WS_RA;
constexpr size_t ACT_BYTES = ((size_t)4 * M + 256) * FF * 2;
constexpr size_t WS_RB = (WS_RA + (ACT_BYTES > (WS_RA_END - WS_RA) ? ACT_BYTES : (WS_RA_END - WS_RA)) + MiB - 1) / MiB * MiB;
constexpr size_t WS_GATES = WS_RB;
constexpr size_t WS_XB = WS_GATES + (size_t)M * 2048 * 2;
constexpr size_t WS_MERGED = WS_XB + (size_t)M * D * 2;
constexpr size_t WS_Y2 = WS_RB;
constexpr size_t WS_W1T = (WS_RB + ACT_BYTES + MiB - 1) / MiB * MiB;
constexpr size_t WS_END = WS_W1T + (size_t)E * 2048 * 1024 * 2;

constexpr int LDS_STAGE = 0;
constexpr int LDS_P0 = 133120;
constexpr int LDS_IDX = 133120;
constexpr int LDS_TAB = LDS_IDX + 2048;
constexpr int LDS_MISC = LDS_TAB + 512;
constexpr int LDS_BYTES = 147456;

struct Params {
    const float* in[27]; float* out; unsigned char* ws; int ph_lo, ph_hi;
};
enum { I_X = 0, I_G1, I_WIN, I_BGATE, I_POOLW, I_PSCALE, I_LRE, I_LIM, I_LOGDT, I_BRE, I_BIM, I_CRE, I_CIM, I_DSK, I_GLUW, I_GLUB, I_WPUP, I_WSUP, I_WOUT, I_G2, I_RW, I_RB, I_W1, I_B1, I_W2, I_B2, I_GF };

#define EPI_ARGS const f32x4 (&acc)[2][2][4][2], const Unit& u, int wr, int wc, int fr, int fq
#define FOR_AI_M _Pragma("unroll") for (int ai = 0; ai < 2; ++ai) _Pragma("unroll") for (int m = 0; m < 4; ++m)
__device__ __forceinline__ u32x4 pack8(const f32x4 a, const f32x4 b) { u32x4 w; w.x = cvt_pk_bf16(a[0], a[1]); w.y = cvt_pk_bf16(a[2], a[3]); w.z = cvt_pk_bf16(b[0], b[1]); w.w = cvt_pk_bf16(b[2], b[3]); return w; }
__device__ __forceinline__ void unpack8(const u32x4 w, f32x4& a, f32x4& b) { a = (f32x4){bflo(w.x), bfhi(w.x), bflo(w.y), bfhi(w.y)}; b = (f32x4){bflo(w.z), bfhi(w.z), bflo(w.w), bfhi(w.w)}; }

struct EpiInProj {
    static constexpr bool PERM = true;
    const float* rstd; const float* bgate; bf16_t* upool; bf16_t* ucat; bf16_t* gates;
    __device__ __forceinline__ void operator()(EPI_ARGS) const {
        const int pn = u.pn;
        FOR_AI_M {
            const int row = u.pm * BM + ai * HALF + wr * 64 + m * 16 + fr; const float rs = rstd[row];
#pragma unroll
            for (int bj = 0; bj < 2; ++bj) {
                const int tc = bj * HALF + wc * 32 + 8 * fq;
                f32x4 v0 = acc[ai][bj][m][0] * rs, v1 = acc[ai][bj][m][1] * rs;
                if (pn < 2) { *(u32x4*)(upool + (size_t)row * 512 + pn * 256 + tc) = pack8(v0, v1); }
                else if (pn < 4) { const int c = (pn - 2) * 256 + tc, g = c >> 4, q0 = c & 15, chunk = row >> 6, s = row & 63;
                    *(u32x4*)(ucat + ((size_t)(g * NCH + chunk) * KCAT + 128 + s * 16 + q0)) = pack8(v0, v1); }
                else { const int c = (pn - 4) * 256 + tc; const f32x4 b0 = *(const f32x4*)(bgate + c), b1 = *(const f32x4*)(bgate + c + 4);
#pragma unroll
                    for (int j = 0; j < 4; ++j) { v0[j] = sigm(v0[j] + b0[j]); v1[j] = sigm(v1[j] + b1[j]); }
                    *(u32x4*)(gates + (size_t)row * 2048 + c) = pack8(v0, v1); }
            }
        }
    }
};
struct EpiSloc {
    static constexpr bool PERM = true;
    float* sloc;
    __device__ __forceinline__ void operator()(EPI_ARGS) const {
        FOR_AI_M { const int chunk = u.pm * BM + ai * HALF + wr * 64 + m * 16 + fr; const int c = wc * 32 + 8 * fq;
            float* p = sloc + ((size_t)(u.g * NCH + chunk) * 128 + c); *(f32x4*)p = acc[ai][0][m][0]; *(f32x4*)(p + 4) = acc[ai][0][m][1]; }
    }
};
struct EpiYpg {
    static constexpr bool PERM = true;
    const bf16_t* gates; bf16_t* ypg;
    __device__ __forceinline__ void operator()(EPI_ARGS) const {
        FOR_AI_M { const int row = u.pm * BM + ai * HALF + wr * 64 + m * 16 + fr;
#pragma unroll
            for (int bj = 0; bj < 2; ++bj) { const int c = u.pn * BM + bj * HALF + wc * 32 + 8 * fq; f32x4 g0, g1; unpack8(*(const u32x4*)(gates + (size_t)row * 2048 + c), g0, g1);
                *(u32x4*)(ypg + (size_t)row * D + c) = pack8(acc[ai][bj][m][0] * g0, acc[ai][bj][m][1] * g1); } }
    }
};
struct EpiSsmY {
    static constexpr bool PERM = true;
    const bf16_t* ucat; const float* dsk; bf16_t* yg;
    __device__ __forceinline__ void operator()(EPI_ARGS) const {
        FOR_AI_M { const int chunk = u.pm * BM + ai * HALF + wr * 64 + m * 16 + fr;
#pragma unroll
            for (int bj = 0; bj < 2; ++bj) { const int c = u.pn * BM + bj * HALF + wc * 32 + 8 * fq, t = c >> 4, p0 = c & 15;
                f32x4 u0, u1; unpack8(*(const u32x4*)(ucat + ((size_t)(u.g * NCH + chunk) * KCAT + 128 + c)), u0, u1);
                const f32x4 d0 = *(const f32x4*)(dsk + u.g * 16 + p0), d1 = *(const f32x4*)(dsk + u.g * 16 + p0 + 4);
                f32x4 v0 = acc[ai][bj][m][0] + d0 * u0, v1 = acc[ai][bj][m][1] + d1 * u1;
#pragma unroll
                for (int j = 0; j < 4; ++j) { v0[j] = gelu_tanh(v0[j]); v1[j] = gelu_tanh(v1[j]); }
                *(u32x4*)(yg + (size_t)(chunk * LCH + t) * 512 + u.g * 16 + p0) = pack8(v0, v1); } }
    }
};
struct EpiGlu {
    static constexpr bool PERM = true;
    const bf16_t* yg; const float* glub; bf16_t* ys;
    __device__ __forceinline__ void operator()(EPI_ARGS) const {
        FOR_AI_M { const int row = u.pm * BM + ai * HALF + wr * 64 + m * 16 + fr;
#pragma unroll
            for (int bj = 0; bj < 2; ++bj) { const int c = u.pn * BM + bj * HALF + wc * 32 + 8 * fq; f32x4 y0, y1; unpack8(*(const u32x4*)(yg + (size_t)row * 512 + c), y0, y1);
                const f32x4 b0 = *(const f32x4*)(glub + c), b1 = *(const f32x4*)(glub + c + 4); f32x4 v0 = acc[ai][bj][m][0] + b0, v1 = acc[ai][bj][m][1] + b1;
#pragma unroll
                for (int j = 0; j < 4; ++j) { v0[j] = y0[j] * sigm(v0[j]); v1[j] = y1[j] * sigm(v1[j]); }
                *(u32x4*)(ys + (size_t)row * 512 + c) = pack8(v0, v1); } }
    }
};
struct EpiMerge {
    static constexpr bool PERM = true;
    const bf16_t* gates; const bf16_t* ypg; bf16_t* merged;
    __device__ __forceinline__ void operator()(EPI_ARGS) const {
        FOR_AI_M { const int row = u.pm * BM + ai * HALF + wr * 64 + m * 16 + fr;
#pragma unroll
            for (int bj = 0; bj < 2; ++bj) { const int c = u.pn * BM + bj * HALF + wc * 32 + 8 * fq; f32x4 g0, g1, p0, p1;
                unpack8(*(const u32x4*)(gates + (size_t)row * 2048 + 1024 + c), g0, g1); unpack8(*(const u32x4*)(ypg + (size_t)row * D + c), p0, p1);
                *(u32x4*)(merged + (size_t)row * D + c) = pack8(p0 + acc[ai][bj][m][0] * g0, p1 + acc[ai][bj][m][1] * g1); } }
    }
};
struct EpiX1 {
    static constexpr bool PERM = true;
    const float* x; float* x1; bf16_t* x1b;
    __device__ __forceinline__ void operator()(EPI_ARGS) const {
        FOR_AI_M { const int row = u.pm * BM + ai * HALF + wr * 64 + m * 16 + fr;
#pragma unroll
            for (int bj = 0; bj < 2; ++bj) { const int c = u.pn * BM + bj * HALF + wc * 32 + 8 * fq; const size_t o = (size_t)row * D + c;
                const f32x4 v0 = *(const f32x4*)(x + o) + acc[ai][bj][m][0], v1 = *(const f32x4*)(x + o + 4) + acc[ai][bj][m][1];
                *(f32x4*)(x1 + o) = v0; *(f32x4*)(x1 + o + 4) = v1; *(u32x4*)(x1b + o) = pack8(v0, v1); } }
    }
};
struct EpiMoe1 {
    static constexpr bool PERM = true;
    const int* lists; const float* rstd2; const float* b1p; bf16_t* act;
    __device__ __forceinline__ void operator()(EPI_ARGS) const {
        const int c = wc * 32 + 8 * fq; const float* bp = b1p + (size_t)u.g * 2048 + u.pn * 256 + c;
        const f32x4 bg0 = *(const f32x4*)bp, bg1 = *(const f32x4*)(bp + 4), bl0 = *(const f32x4*)(bp + 128), bl1 = *(const f32x4*)(bp + 132);
        FOR_AI_M { const int r = ai * HALF + wr * 64 + m * 16 + fr;
            if (r < u.rows) { const int tok = lists[(size_t)u.g * M + u.pm * BM + r]; const float rs = rstd2[tok];
                f32x4 a0 = acc[ai][0][m][0] * rs + bg0, a1 = acc[ai][0][m][1] * rs + bg1, l0 = acc[ai][1][m][0] * rs + bl0, l1 = acc[ai][1][m][1] * rs + bl1;
#pragma unroll
                for (int j = 0; j < 4; ++j) { float a = fminf(a0[j], 7.f), l = fminf(fmaxf(l0[j], -7.f), 7.f); a0[j] = a * sigm(1.702f * a) * (l + 1.f);
                    a = fminf(a1[j], 7.f); l = fminf(fmaxf(l1[j], -7.f), 7.f); a1[j] = a * sigm(1.702f * a) * (l + 1.f); }
                *(u32x4*)(act + (size_t)(u.rb + r) * FF + u.pn * 128 + c) = pack8(a0, a1); } }
    }
};
struct EpiMoe2 {
    static constexpr bool PERM = true;
    const float* b2; bf16_t* y2;
    __device__ __forceinline__ void operator()(EPI_ARGS) const {
        FOR_AI_M { const int r = ai * HALF + wr * 64 + m * 16 + fr;
            if (r < u.rows) {
#pragma unroll
                for (int bj = 0; bj < 2; ++bj) { const int c = u.pn * BM + bj * HALF + wc * 32 + 8 * fq; const float* bp = b2 + (size_t)u.g * D + c;
                    *(u32x4*)(y2 + (size_t)(u.rb + r) * D + c) = pack8(acc[ai][bj][m][0] + *(const f32x4*)bp, acc[ai][bj][m][1] + *(const f32x4*)(bp + 4)); } } }
    }
};

struct SchedDense {
    GridOrder o; const char* A; const char* B; unsigned lda, ldb; int nt;
    __device__ bool next(int i, Unit& u) const { int pm, pn; if (!o.next(i, pm, pn)) return false; u.A = A + (size_t)pm * BM * lda; u.B = B + (size_t)pn * BM * ldb; u.nt = nt; u.pm = pm; u.pn = pn; u.g = 0; u.rows = BM; u.rb = 0; return true; }
    __device__ int row_off(const Unit&, int) const { return 0; }
};
struct SchedSloc {
    const char* ucat; const char* mst; int G, c;
    __device__ bool next(int i, Unit& u) const { const int L = i * G + c; if (L >= NG * 2) return false; const int g = L >> 1, pm = L & 1;
        u.A = ucat + ((size_t)(g * NCH + pm * BM) * KCAT + 128) * 2; u.B = mst + (size_t)g * 256 * 1024 * 2; u.nt = 16; u.pm = pm; u.pn = 0; u.g = g; u.rows = BM; u.rb = 0; return true; }
    __device__ int row_off(const Unit&, int) const { return 0; }
};
struct SchedSsmY {
    const char* ucat; const char* bcat; int G, c;
    __device__ bool next(int i, Unit& u) const { const int L = i * G + c; if (L >= NG * 8) return false; const int pn = 3 - (L >> 6), r = L & 63, g = r >> 1, pm = r & 1;
        u.A = ucat + (size_t)(g * NCH + pm * BM) * KCAT * 2; u.B = bcat + (size_t)(g * 1024 + pn * BM) * KCAT * 2; u.nt = 2 + 4 * (pn + 1); u.pm = pm; u.pn = pn; u.g = g; u.rows = BM; u.rb = 0; return true; }
    __device__ int row_off(const Unit&, int) const { return 0; }
};
struct SchedMoe {
    const LAS int* tab; const int* lists; const char* A; const char* B; unsigned lda; size_t bstride_e; unsigned ldb; int npn; int G, c; bool gather;
    __device__ bool next(int i, Unit& u) const {
        const int U = tab[32] * npn, x = c & 7, idx = c >> 3, per = G >> 3;
        const int lo = (int)(((long)U * x) / 8), hi = (int)(((long)U * (x + 1)) / 8);
        const int L = lo + i * per + idx; if (L >= hi) return false;
        const int mtg = L / npn, pn = L - mtg * npn; int e = 0;
        for (int k = 1; k < E; ++k) e += (tab[k] <= mtg) ? 1 : 0;
        const int mt = mtg - tab[e], cn = tab[72 + e], of = tab[40 + e];
        u.g = e; u.pm = mt; u.pn = pn; u.rows = (cn - mt * BM) < BM ? (cn - mt * BM) : BM; u.rb = of + mt * BM; u.nt = 16;
        u.A = A + (size_t)u.rb * lda; u.B = B + (size_t)e * bstride_e + (size_t)pn * BM * ldb; return true;
    }
    __device__ int row_off(const Unit& u, int r) const { return (r < u.rows) ? lists[(size_t)u.g * M + u.pm * BM + r] * (D * 2) : 0; }
};
__device__ __forceinline__ void moe_tables(LAS int* tab, const unsigned* cnt) {
    if (threadIdx.x == 0) { int tc = 0, of = 0; for (int e = 0; e < E; ++e) { const int c = (int)cnt[e]; tab[e] = tc; tab[40 + e] = of; tab[72 + e] = c; tc += (c + BM - 1) / BM; of += c; } tab[32] = tc; }
    LDS_WAIT(); __syncthreads();
}

__device__ __forceinline__ void p0_xrow(const float* xrow, bf16_t* orow, float* rstd_out, int lane) {
    const f32x4* xr = (const f32x4*)xrow + lane; f32x4 v[4]; float s = 0.f;
#pragma unroll
    for (int j = 0; j < 4; ++j) { v[j] = xr[64 * j]; s += (v[j].x * v[j].x + v[j].y * v[j].y) + (v[j].z * v[j].z + v[j].w * v[j].w); }
    s = wave_sum(s);
    if (lane == 0) *rstd_out = 1.0f / sqrtf(s * (1.f / D) + 1e-6f);
    u32x2* o8 = (u32x2*)orow + lane;
#pragma unroll
    for (int j = 0; j < 4; ++j) { u32x2 w; w.x = pk2(v[j].x, v[j].y); w.y = pk2(v[j].z, v[j].w); o8[64 * j] = w; }
}
template <bool SWIGLU_PERM>
__device__ __forceinline__ void p0_transpose_item(const float* W, int K, int N, const float* kscale, bf16_t* WT, LAS float* scr, int item, int lane) {
    const int nblk = N / 64, kb = item / nblk, nb = item - kb * nblk, k0 = 64 * kb, n0 = 64 * nb;
#pragma unroll 4
    for (int i = 0; i < 16; ++i) { const int kk = 4 * i + (lane >> 4); f32x4 v = *(const f32x4*)(W + (size_t)(k0 + kk) * N + n0 + 4 * (lane & 15));
        if (kscale) v = v * kscale[k0 + kk];
        LAS float* s = scr + kk * 65 + 4 * (lane & 15); s[0] = v.x; s[1] = v.y; s[2] = v.z; s[3] = v.w; }
    LDS_WAIT(); asm volatile("" ::: "memory");
    const int c = lane & 7;
#pragma unroll
    for (int j = 0; j < 8; ++j) { const int n = (lane >> 3) + 8 * j; const LAS float* s = scr + (8 * c) * 65 + n;
        u32x4 o; o.x = pk2(s[0 * 65], s[1 * 65]); o.y = pk2(s[2 * 65], s[3 * 65]); o.z = pk2(s[4 * 65], s[5 * 65]); o.w = pk2(s[6 * 65], s[7 * 65]);
        int nn = n0 + n; if (SWIGLU_PERM) { const int jj = nn >> 1, bj = nn & 1; nn = (jj >> 7) * 256 + bj * 128 + (jj & 127); }
        *(u32x4*)(WT + (size_t)nn * K + k0 + 8 * c) = o; }
    LDS_WAIT(); asm volatile("" ::: "memory");
}
__device__ __forceinline__ void p0_ssm_consts(const Params& P, int g, LAS unsigned char* lds) {
    LAS f32x2* lbp = (LAS f32x2*)lds;
    LAS f32x2* Bb = lbp + 65 * 64;
    LAS f32x2* Cc = Bb + 64 * 16;
    const int tid = threadIdx.x;
    const float dt = expf(P.in[I_LOGDT][g]);
#pragma unroll 1
    for (int idx = tid; idx < 65 * 64; idx += NTHR) { const int k = idx >> 6, n = idx & 63; const float lr = P.in[I_LRE][g * 64 + n], li = P.in[I_LIM][g * 64 + n];
        const double th = (double)li * (double)dt * (double)k; const double nrev = __builtin_rint(th * 0.15915494309189535); const float r = (float)(th - nrev * 6.283185307179586);
        const float mag = expf(lr * dt * (float)k); lbp[idx] = (f32x2){mag * cosf(r), mag * sinf(r)}; }
#pragma unroll 1
    for (int idx = tid; idx < 64 * 16; idx += NTHR) { const int n = idx >> 4, q = idx & 15; const double lr = P.in[I_LRE][g * 64 + n], li = P.in[I_LIM][g * 64 + n];
        const double th = li * (double)dt; const double nrev = __builtin_rint(th * 0.15915494309189535); const float r = (float)(th - nrev * 6.283185307179586);
        const double mag = (double)expf((float)(lr * (double)dt)); const double lbr = mag * (double)cosf(r), lbi = mag * (double)sinf(r);
        const double den = lr * lr + li * li, xr = lbr - 1.0, xi = lbi; const double fr = (xr * lr + xi * li) / den, fi = (xi * lr - xr * li) / den;
        const double br = P.in[I_BRE][(g * 64 + n) * 16 + q], bi = P.in[I_BIM][(g * 64 + n) * 16 + q];
        Bb[idx] = (f32x2){(float)(fr * br - fi * bi), (float)(fr * bi + fi * br)}; }
    for (int idx = tid; idx < 16 * 64; idx += NTHR) Cc[idx] = (f32x2){P.in[I_CRE][g * 1024 + idx], P.in[I_CIM][g * 1024 + idx]};
    LDS_WAIT(); __syncthreads();
    float* lb64 = (float*)(P.ws + WS_LB64);
    if (tid < 64) { const f32x2 z = lbp[64 * 64 + tid]; lb64[(g * 64 + tid) * 2] = z.x; lb64[(g * 64 + tid) * 2 + 1] = z.y; }
    bf16_t* mst = (bf16_t*)(P.ws + WS_MST) + (size_t)g * 256 * 1024;
#pragma unroll 1
    for (int idx = tid; idx < 256 * 128; idx += NTHR) { const int np = idx >> 7, c8 = (idx & 127) * 8; u32x4 o = (u32x4){0u, 0u, 0u, 0u};
        if (np < 128) { const int n = np & 63, s = c8 >> 4, q0 = c8 & 15; const f32x2 l = lbp[(63 - s) * 64 + n]; float v[8];
#pragma unroll
            for (int j = 0; j < 8; ++j) { const f32x2 b = Bb[n * 16 + q0 + j]; v[j] = (np < 64) ? (l.x * b.x - l.y * b.y) : (l.x * b.y + l.y * b.x); }
            o.x = pk2(v[0], v[1]); o.y = pk2(v[2], v[3]); o.z = pk2(v[4], v[5]); o.w = pk2(v[6], v[7]); }
        *(u32x4*)(mst + (size_t)np * 1024 + c8) = o; }
    bf16_t* bcat = (bf16_t*)(P.ws + WS_BCAT) + (size_t)g * 1024 * KCAT;
#pragma unroll 1
    for (int idx = tid; idx < 1024 * 16; idx += NTHR) { const int row = idx >> 4, c8 = (idx & 15) * 8, t = row >> 4, p = row & 15; float v[8];
#pragma unroll
        for (int j = 0; j < 8; ++j) { const int np = c8 + j, n = np & 63; const f32x2 l = lbp[(t + 1) * 64 + n], cc = Cc[p * 64 + n];
            v[j] = (np < 64) ? (cc.x * l.x - cc.y * l.y) : -(cc.x * l.y + cc.y * l.x); }
        u32x4 o; o.x = pk2(v[0], v[1]); o.y = pk2(v[2], v[3]); o.z = pk2(v[4], v[5]); o.w = pk2(v[6], v[7]);
        *(u32x4*)(bcat + (size_t)row * KCAT + c8) = o; }
    float* kern = (float*)(P.ws + WS_KERN) + (size_t)g * 64 * 256;
#pragma unroll 1
    for (int idx = tid; idx < 64 * 256; idx += NTHR) { const int k = idx >> 8, p = (idx >> 4) & 15, q = idx & 15; float s = 0.f;
#pragma unroll 4
        for (int n = 0; n < 64; ++n) { const f32x2 l = lbp[k * 64 + n], cc = Cc[p * 64 + n], b = Bb[n * 16 + q]; const float zr = cc.x * l.x - cc.y * l.y, zi = cc.x * l.y + cc.y * l.x; s += zr * b.x - zi * b.y; }
        kern[idx] = s; }
    __syncthreads();
}
__device__ __forceinline__ void p0_wcomb_item(const Params& P, int cg, int lane) {
    const int g = cg >> 7; const float* pw = P.in[I_POOLW] + (size_t)cg * 128; const float* sc = P.in[I_PSCALE] + g * 128; const float* up = P.in[I_WPUP] + (size_t)g * 128 * D;
    float a[16];
#pragma unroll
    for (int i = 0; i < 16; ++i) a[i] = 0.f;
    for (int j = 0; j < 128; ++j) { const float w = pw[j] * sc[j]; const float* ur = up + (size_t)j * D + lane;
#pragma unroll
        for (int i = 0; i < 16; ++i) a[i] += w * ur[64 * i]; }
    bf16_t* o = (bf16_t*)(P.ws + WS_WCOMB);
#pragma unroll
    for (int i = 0; i < 16; ++i) o[(size_t)(lane + 64 * i) * 512 + cg] = (bf16_t)f2bf(a[i]);
}
__device__ __forceinline__ void p0_prologue(const Params& P, LAS unsigned char* lds, int vcu, int G) {
    const int tid = threadIdx.x, lane = tid & 63, wave = __builtin_amdgcn_readfirstlane(tid >> 6);
#ifndef P0_SKIP_SSM
    if (blockIdx.x < NG) p0_ssm_consts(P, blockIdx.x, lds);
#endif
    LAS float* scr = (LAS float*)(lds + wave * 16640);
    const int gw = vcu * NWAVES + wave, NGW = G * NWAVES;
    constexpr int I_IN = 16 * 48, I_GL = 8 * 8, I_SU = 8 * 16, I_WO = 16 * 16, I_1 = 16 * 32, I_2 = 16 * 16;
    constexpr int NIT = I_IN + I_GL + I_SU + I_WO + E * I_1 + E * I_2;
#ifndef P0_SKIP_TR
    for (int it = gw; it < NIT; it += NGW) {
        int r = it;
        if (r < I_IN) { p0_transpose_item<false>(P.in[I_WIN], D, 3072, P.in[I_G1], (bf16_t*)(P.ws + WS_WIN), scr, r, lane); continue; } r -= I_IN;
        if (r < I_GL) { p0_transpose_item<false>(P.in[I_GLUW], 512, 512, nullptr, (bf16_t*)(P.ws + WS_GLU), scr, r, lane); continue; } r -= I_GL;
        if (r < I_SU) { p0_transpose_item<false>(P.in[I_WSUP], 512, D, nullptr, (bf16_t*)(P.ws + WS_WSUP), scr, r, lane); continue; } r -= I_SU;
        if (r < I_WO) { p0_transpose_item<false>(P.in[I_WOUT], D, D, nullptr, (bf16_t*)(P.ws + WS_WOUT), scr, r, lane); continue; } r -= I_WO;
        if (r < E * I_1) { const int e = r / I_1; p0_transpose_item<true>(P.in[I_W1] + (size_t)e * D * 2048, D, 2048, P.in[I_G2], (bf16_t*)(P.ws + WS_W1T) + (size_t)e * 2048 * D, scr, r - e * I_1, lane); continue; } r -= E * I_1;
        { const int e = r / I_2; p0_transpose_item<false>(P.in[I_W2] + (size_t)e * FF * D, FF, D, nullptr, (bf16_t*)(P.ws + WS_W2T) + (size_t)e * D * FF, scr, r - e * I_2, lane); }
    }
#endif
#ifndef P0_SKIP_WC
    for (int cg = gw; cg < 512; cg += NGW) p0_wcomb_item(P, cg, lane);
#endif
    for (int m = gw; m < M; m += NGW) p0_xrow(P.in[I_X] + (size_t)m * D, (bf16_t*)(P.ws + WS_XB) + (size_t)m * D, (float*)(P.ws + WS_RSTD1) + m, lane);
    const int gt = vcu * NTHR + tid, NGT = G * NTHR;
    for (int i = gt; i < E * D; i += NGT) { const int e = i >> 10, k = i & 1023; ((float*)(P.ws + WS_RWT))[i] = P.in[I_RW][k * E + e] * P.in[I_G2][k]; }
    for (int i = gt; i < E * 2048; i += NGT) { const int e = i >> 11, n = i & 2047, jj = n >> 1, bj = n & 1, np = (jj >> 7) * 256 + bj * 128 + (jj & 127); ((float*)(P.ws + WS_B1P))[e * 2048 + np] = P.in[I_B1][i]; }
}

__device__ __forceinline__ void p2_stream(const Params& P, int vcu, int G) {
    const int gt = vcu * NTHR + threadIdx.x, NGT = G * NTHR;
    const bf16_t* up = (const bf16_t*)(P.ws + WS_UPOOL); bf16_t* dp = (bf16_t*)(P.ws + WS_DPOOL);
    for (int id = gt; id < M * 64; id += NGT) { const int c8 = id & 63, tok = id >> 6, g = c8 >> 4, w = 2 << g, ts = tok & (T - 1), n = (ts + 1 < w) ? ts + 1 : w;
        const bf16_t* p = up + (size_t)tok * 512 + c8 * 8; f32x4 s0 = (f32x4){0.f, 0.f, 0.f, 0.f}, s1 = s0, u0, u1; unpack8(*(const u32x4*)p, u0, u1); s0 = u0; s1 = u1;
        for (int j = 1; j < n; ++j) { f32x4 a, b; unpack8(*(const u32x4*)(p - (size_t)j * 512), a, b); s0 += a; s1 += b; }
        const float inv = 1.f / (float)n; *(u32x4*)(dp + (size_t)tok * 512 + c8 * 8) = pack8(s0 * inv - u0, s1 * inv - u1); }
    const float* kern = (const float*)(P.ws + WS_KERN); bf16_t* bcat = (bf16_t*)(P.ws + WS_BCAT);
    for (int id = gt; id < NG * 1024 * 128; id += NGT) { const int g = id >> 17, row = (id >> 7) & 1023, c8 = id & 127, t = row >> 4, p = row & 15, s = c8 >> 1, q0 = (c8 & 1) * 8;
        u32x4 o = (u32x4){0u, 0u, 0u, 0u};
        if (s <= t) { const float* kp = kern + ((size_t)g * 64 + (t - s)) * 256 + p * 16 + q0; o = pack8(*(const f32x4*)kp, *(const f32x4*)(kp + 4)); }
        *(u32x4*)(bcat + ((size_t)g * 1024 + row) * KCAT + 128 + s * 16 + q0) = o; }
}
__device__ __forceinline__ void p3_scan(const Params& P, int vcu, int G) {
    if (threadIdx.x >= 64) return;
    const int n = threadIdx.x; const float* lb64 = (const float*)(P.ws + WS_LB64); const float* sloc = (const float*)(P.ws + WS_SLOC); bf16_t* ucat = (bf16_t*)(P.ws + WS_UCAT);
    for (int pr = vcu; pr < NB * NG; pr += G) { const int b = pr >> 5, g = pr & 31; const float ar = lb64[(g * 64 + n) * 2], ai = lb64[(g * 64 + n) * 2 + 1]; float cr = 0.f, ci = 0.f;
        for (int cb = 0; cb < 64; cb += 8) { float sr[8], si[8];
#pragma unroll
            for (int j = 0; j < 8; ++j) { const float* sl = sloc + (size_t)(g * NCH + b * 64 + cb + j) * 128; sr[j] = sl[n]; si[j] = sl[64 + n]; }
#pragma unroll
            for (int j = 0; j < 8; ++j) { bf16_t* u = ucat + (size_t)(g * NCH + b * 64 + cb + j) * KCAT; u[n] = (bf16_t)f2bf(cr); u[64 + n] = (bf16_t)f2bf(ci);
                const float nr = ar * cr - ai * ci + sr[j], ni = ar * ci + ai * cr + si[j]; cr = nr; ci = ni; } } }
}
__device__ __forceinline__ void p5_router(const Params& P, int vcu, int G) {
    const int tid = threadIdx.x, lane = tid & 63, wave = __builtin_amdgcn_readfirstlane(tid >> 6), ti = lane & 15, kq = lane >> 4;
    const int gw = vcu * NWAVES + wave, NGW = G * NWAVES;
    const float* x1 = (const float*)(P.ws + WS_X1); const float* rwt = (const float*)(P.ws + WS_RWT); const float* rb = P.in[I_RB];
    unsigned* cnt = (unsigned*)(P.ws + WS_CTL) + CW_CNT; int* lists = (int*)(P.ws + WS_LISTS);
    int* tok_e = (int*)(P.ws + WS_TOKE); int* tok_p = (int*)(P.ws + WS_TOKP); float* tok_g = (float*)(P.ws + WS_TOKG); float* rstd2 = (float*)(P.ws + WS_RSTD2);
    for (int tg = gw; tg < M / 16; tg += NGW) {
        const int tok = tg * 16 + ti; const float* xr = x1 + (size_t)tok * D + 4 * kq; const float* w0p = rwt + (size_t)ti * D + 4 * kq; const float* w1p = w0p + 16 * D;
        f32x4 a0 = (f32x4){0.f, 0.f, 0.f, 0.f}, a1 = a0; float ss = 0.f;
#pragma unroll 4
        for (int j = 0; j < 64; ++j) { const f32x4 xa = *(const f32x4*)(xr + 16 * j), w0 = *(const f32x4*)(w0p + 16 * j), w1 = *(const f32x4*)(w1p + 16 * j);
            ss += (xa.x * xa.x + xa.y * xa.y) + (xa.z * xa.z + xa.w * xa.w);
#pragma unroll
            for (int c = 0; c < 4; ++c) { a0 = __builtin_amdgcn_mfma_f32_16x16x4f32(w0[c], xa[c], a0, 0, 0, 0); a1 = __builtin_amdgcn_mfma_f32_16x16x4f32(w1[c], xa[c], a1, 0, 0, 0); } }
        ss += __shfl_xor(ss, 16); ss += __shfl_xor(ss, 32);
        const float rs = 1.0f / sqrtf(ss * (1.f / D) + 1e-6f);
        float v[8];
#pragma unroll
        for (int r = 0; r < 4; ++r) { v[r] = a0[r] * rs + rb[4 * kq + r]; v[4 + r] = a1[r] * rs + rb[16 + 4 * kq + r]; }
        float sv[4]; int se[4];
#pragma unroll
        for (int k = 0; k < 4; ++k) {
            float best = v[0]; int bi = 4 * kq;
#pragma unroll
            for (int r = 1; r < 8; ++r) { const int e = (r < 4) ? 4 * kq + r : 16 + 4 * kq + (r - 4); if (v[r] > best) { best = v[r]; bi = e; } }
#pragma unroll
            for (int o = 16; o < 64; o <<= 1) { const float ov = __shfl_xor(best, o); const int oi = __shfl_xor(bi, o); if (ov > best || (ov == best && oi < bi)) { best = ov; bi = oi; } }
            sv[k] = best; se[k] = bi;
#pragma unroll
            for (int r = 0; r < 8; ++r) { const int e = (r < 4) ? 4 * kq + r : 16 + 4 * kq + (r - 4); if (e == bi) v[r] = -3.0e38f; }
        }
        const float e0 = __expf(sv[0] - sv[0]), e1 = __expf(sv[1] - sv[0]), e2 = __expf(sv[2] - sv[0]), e3 = __expf(sv[3] - sv[0]); const float inv = 1.f / (e0 + e1 + e2 + e3);
        const int myk = kq; const int me = (myk == 0) ? se[0] : (myk == 1) ? se[1] : (myk == 2) ? se[2] : se[3]; const float mg = ((myk == 0) ? e0 : (myk == 1) ? e1 : (myk == 2) ? e2 : e3) * inv;
        const int pos = (int)__hip_atomic_fetch_add(cnt + me, 1u, __ATOMIC_RELAXED, __HIP_MEMORY_SCOPE_AGENT);
        lists[(size_t)me * M + pos] = tok; tok_e[tok * 4 + myk] = me; tok_p[tok * 4 + myk] = pos; tok_g[tok * 4 + myk] = mg;
        if (kq == 0) rstd2[tok] = rs;
    }
}
__device__ __forceinline__ void p9_final(const Params& P, const LAS int* tab, int vcu, int G) {
    const int tid = threadIdx.x, lane = tid & 63, wave = __builtin_amdgcn_readfirstlane(tid >> 6);
    const int gw = vcu * NWAVES + wave, NGW = G * NWAVES;
    const float* x1 = (const float*)(P.ws + WS_X1); const bf16_t* y2 = (const bf16_t*)(P.ws + WS_Y2); const float* gf = P.in[I_GF];
    const int* tok_e = (const int*)(P.ws + WS_TOKE); const int* tok_p = (const int*)(P.ws + WS_TOKP); const float* tok_g = (const float*)(P.ws + WS_TOKG);
    for (int tok = gw; tok < M; tok += NGW) {
        const f32x4* xr = (const f32x4*)(x1 + (size_t)tok * D) + lane; f32x4 v[4];
#pragma unroll
        for (int j = 0; j < 4; ++j) v[j] = xr[64 * j];
#pragma unroll
        for (int k = 0; k < 4; ++k) { const int e = tok_e[tok * 4 + k]; const int row = tab[40 + e] + tok_p[tok * 4 + k]; const float g = tok_g[tok * 4 + k];
            const u32x2* yr = (const u32x2*)(y2 + (size_t)row * D) + lane;
#pragma unroll
            for (int j = 0; j < 4; ++j) { const u32x2 w = yr[64 * j]; v[j].x += g * bflo(w.x); v[j].y += g * bfhi(w.x); v[j].z += g * bflo(w.y); v[j].w += g * bfhi(w.y); } }
        float s = 0.f;
#pragma unroll
        for (int j = 0; j < 4; ++j) s += (v[j].x * v[j].x + v[j].y * v[j].y) + (v[j].z * v[j].z + v[j].w * v[j].w);
        s = wave_sum(s); const float r = 1.0f / sqrtf(s * (1.f / D) + 1e-6f);
        f32x4* orow = (f32x4*)(P.out + (size_t)tok * D) + lane; const f32x4* gr = (const f32x4*)gf + lane;
#pragma unroll
        for (int j = 0; j < 4; ++j) orow[64 * j] = v[j] * r * gr[64 * j];
    }
}

constexpr int NPHASE = 12;
__global__ void __launch_bounds__(NTHR, 2) mega(Params P) {
    extern __shared__ __attribute__((aligned(16))) unsigned char lds_raw[];
    LAS unsigned char* lds = (LAS unsigned char*)lds_raw;
    const int tid = threadIdx.x; const int G = gridDim.x; const int bx = blockIdx.x;
    const int vcu = (G % 8 == 0) ? (bx % 8) * (G / 8) + bx / 8 : bx;
    LAS int* idxl = (LAS int*)(lds + LDS_IDX); LAS int* tab = (LAS int*)(lds + LDS_TAB); volatile LAS unsigned* misc = (volatile LAS unsigned*)(lds + LDS_MISC);
    if (tid < 64) misc[tid] = 0u;
    __syncthreads();
    const bool multi = (P.ph_hi - P.ph_lo) > 1;
    XcdBarrier bar; bar.bar = (unsigned*)(P.ws + WS_CTL) + CW_BAR; bar.x = 0; bar.st = misc;
    if (multi) bar = xcd_barrier_post((unsigned*)(P.ws + WS_CTL) + CW_BAR, misc);
    const int lo = P.ph_lo, hi = P.ph_hi;
#ifndef PH_MASK
#define PH_MASK 0xFFFF
#endif
#define IN(k) (((PH_MASK >> (k)) & 1) && lo <= (k) && (k) < hi)
#define SEAM(k) do { if (IN(k) && IN((k) + 1)) xcd_barrier(bar); } while (0)
    unsigned char* ws = P.ws;
    if (IN(0)) { p0_prologue(P, lds, vcu, G); }
    SEAM(0);
    if (IN(1)) {
        SchedDense S; S.o.init(M / BM, 3072 / BM, G, bx); S.A = (const char*)(ws + WS_XB); S.B = (const char*)(ws + WS_WIN); S.lda = D * 2; S.ldb = D * 2; S.nt = D / BK;
        EpiInProj Ep{(const float*)(ws + WS_RSTD1), P.in[I_BGATE], (bf16_t*)(ws + WS_UPOOL), (bf16_t*)(ws + WS_UCAT), (bf16_t*)(ws + WS_GATES)};
        gemm_phase<EpiInProj, SchedDense, false>(lds, idxl, nullptr, S.lda, S.ldb, S, Ep);
    }
    SEAM(1);
    if (IN(2)) {
        p2_stream(P, vcu, G);
        SchedSloc S{(const char*)(ws + WS_UCAT), (const char*)(ws + WS_MST), G, bx};
        EpiSloc Ep{(float*)(ws + WS_SLOC)};
        gemm_phase<EpiSloc, SchedSloc, false>(lds, idxl, nullptr, KCAT * 2, 1024 * 2, S, Ep);
    }
    SEAM(2);
    if (IN(3)) {
        p3_scan(P, vcu, G);
        SchedDense S; S.o.init(M / BM, D / BM, G, bx); S.A = (const char*)(ws + WS_DPOOL); S.B = (const char*)(ws + WS_WCOMB); S.lda = 512 * 2; S.ldb = 512 * 2; S.nt = 512 / BK;
        EpiYpg Ep{(const bf16_t*)(ws + WS_GATES), (bf16_t*)(ws + WS_YPG)};
        gemm_phase<EpiYpg, SchedDense, false>(lds, idxl, nullptr, S.lda, S.ldb, S, Ep);
    }
    SEAM(3);
    if (IN(4)) {
        SchedSsmY S{(const char*)(ws + WS_UCAT), (const char*)(ws + WS_BCAT), G, bx};
        EpiSsmY Ep{(const bf16_t*)(ws + WS_UCAT), P.in[I_DSK], (bf16_t*)(ws + WS_YG)};
        gemm_phase<EpiSsmY, SchedSsmY, false>(lds, idxl, nullptr, KCAT * 2, KCAT * 2, S, Ep);
    }
    SEAM(4);
    if (IN(5)) {
        SchedDense S; S.o.init(M / BM, 512 / BM, G, bx); S.A = (const char*)(ws + WS_YG); S.B = (const char*)(ws + WS_GLU); S.lda = 512 * 2; S.ldb = 512 * 2; S.nt = 512 / BK;
        EpiGlu Ep{(const bf16_t*)(ws + WS_YG), P.in[I_GLUB], (bf16_t*)(ws + WS_YS)};
        gemm_phase<EpiGlu, SchedDense, false>(lds, idxl, nullptr, S.lda, S.ldb, S, Ep);
    }
    SEAM(5);
    if (IN(6)) {
        SchedDense S; S.o.init(M / BM, D / BM, G, bx); S.A = (const char*)(ws + WS_YS); S.B = (const char*)(ws + WS_WSUP); S.lda = 512 * 2; S.ldb = 512 * 2; S.nt = 512 / BK;
        EpiMerge Ep{(const bf16_t*)(ws + WS_GATES), (const bf16_t*)(ws + WS_YPG), (bf16_t*)(ws + WS_MERGED)};
        gemm_phase<EpiMerge, SchedDense, false>(lds, idxl, nullptr, S.lda, S.ldb, S, Ep);
    }
    SEAM(6);
    if (IN(7)) {
        SchedDense S; S.o.init(M / BM, D / BM, G, bx); S.A = (const char*)(ws + WS_MERGED); S.B = (const char*)(ws + WS_WOUT); S.lda = D * 2; S.ldb = D * 2; S.nt = D / BK;
        EpiX1 Ep{P.in[I_X], (float*)(ws + WS_X1), (bf16_t*)(ws + WS_X1B)};
        gemm_phase<EpiX1, SchedDense, false>(lds, idxl, nullptr, S.lda, S.ldb, S, Ep);
    }
    SEAM(7);
    if (IN(8)) { p5_router(P, vcu, G); }
    SEAM(8);
    if (IN(9)) {
        moe_tables(tab, (const unsigned*)(ws + WS_CTL) + CW_CNT);
        SchedMoe S{tab, (const int*)(ws + WS_LISTS), (const char*)(ws + WS_X1B), (const char*)(ws + WS_W1T), 0u, (size_t)2048 * D * 2, D * 2, 8, G, bx, true};
        EpiMoe1 Ep{(const int*)(ws + WS_LISTS), (const float*)(ws + WS_RSTD2), (const float*)(ws + WS_B1P), (bf16_t*)(ws + WS_ACT)};
        gemm_phase<EpiMoe1, SchedMoe, true>(lds, idxl, (const char*)(ws + WS_X1B), 0u, D * 2, S, Ep);
    }
    SEAM(9);
    if (IN(10)) {
        moe_tables(tab, (const unsigned*)(ws + WS_CTL) + CW_CNT);
        SchedMoe S{tab, (const int*)(ws + WS_LISTS), (const char*)(ws + WS_ACT), (const char*)(ws + WS_W2T), FF * 2, (size_t)D * FF * 2, FF * 2, 4, G, bx, false};
        EpiMoe2 Ep{P.in[I_B2], (bf16_t*)(ws + WS_Y2)};
        gemm_phase<EpiMoe2, SchedMoe, false>(lds, idxl, nullptr, FF * 2, FF * 2, S, Ep);
    }
    SEAM(10);
    if (IN(11)) {
        moe_tables(tab, (const unsigned*)(ws + WS_CTL) + CW_CNT);
        p9_final(P, tab, vcu, G);
    }
#undef IN
#undef SEAM
}

static int g_grid = 0;
static bool mk_setup() {
    if (g_grid) return g_grid > 0;
    int dev = 0, cus = 0, per_cu = 0;
    if (hipGetDevice(&dev) != hipSuccess || hipDeviceGetAttribute(&cus, hipDeviceAttributeMultiprocessorCount, dev) != hipSuccess) { g_grid = -1; return false; }
    if (hipFuncSetAttribute((const void*)mega, hipFuncAttributeMaxDynamicSharedMemorySize, LDS_BYTES) != hipSuccess) { fprintf(stderr, "mk_setup: hipFuncSetAttribute failed\n"); g_grid = -1; return false; }
    if (hipOccupancyMaxActiveBlocksPerMultiprocessor(&per_cu, (const void*)mega, NTHR, LDS_BYTES) != hipSuccess || per_cu < 1) { fprintf(stderr, "mk_setup: occupancy query says %d\n", per_cu); g_grid = -1; return false; }
    (void)hipGetLastError();
    g_grid = cus;
    return true;
}
static void mk_launch(const Params& P0, int lo, int hi, hipStream_t st) {
    Params P = P0; P.ph_lo = lo; P.ph_hi = hi;
    hipLaunchKernelGGL(mega, dim3(g_grid), dim3(NTHR), LDS_BYTES, st, P);
}
}
extern "C" void kernel_launch(void* const* d_in, const int* in_sizes, int n_in, void* d_out, int out_size, void* d_ws, size_t ws_size, hipStream_t stream) {
    if (n_in != 27 || out_size != mk::M * mk::D || ws_size < mk::WS_END) { fprintf(stderr, "kernel_launch: unexpected shapes n_in %d out %d ws %zu (need %zu)\n", n_in, out_size, ws_size, (size_t)mk::WS_END); return; }
    if (!mk::mk_setup()) return;
    mk::Params P{};
    for (int i = 0; i < 27; ++i) P.in[i] = (const float*)d_in[i];
    P.out = (float*)d_out; P.ws = (unsigned char*)d_ws;
    (void)hipMemsetAsync((char*)d_ws + mk::WS_CTL, 0, mk::CTL_BYTES, stream);
#if MK_SINGLE
    mk::mk_launch(P, 0, mk::NPHASE, stream);
#else
    for (int p = 0; p < mk::NPHASE; ++p) mk::mk_launch(P, p, p + 1, stream);
#endif
}
```
